# Optimizing an MI355X kernel written in HIP

```python
import math
import jax, jax.numpy as jnp
from jax import lax
import numpy as np

D_MODEL = 2048
BATCH = 4
SEQ = 2048
DEPTH = 1
DEC_BATCH = 128
DEC_SEQ = 1
PAST_LEN = 16384
PAGE_SIZE = 128

D_RNN = D_MODEL // 2
RNN_HEADS = 8
RNN_HD = D_RNN // RNN_HEADS
CONV_W = 4
LRU_C = 8.0
D_MLSTM = D_MODEL // 2
MLSTM_HEADS = 4
MLSTM_HD = D_MLSTM // MLSTM_HEADS
CHUNK = 128
N_MEM = 256
X_HEADS = 4
X_HD = D_MODEL // X_HEADS
D_FF = 4 * D_MODEL
EPS = 1e-6
OFF_RX = 0
OFF_RG = OFF_RX + D_RNN
OFF_MU = OFF_RG + D_RNN
OFF_MV = OFF_MU + D_MLSTM
OFF_MO = OFF_MV + D_MLSTM
OFF_MI = OFF_MO + D_MLSTM
OFF_MF = OFF_MI + MLSTM_HEADS
D_IN = OFF_MF + MLSTM_HEADS

kernel_name = "hymba_rglru_mlstm_memxattn_step"


def rmsnorm(x, g):
    xf = x.astype(jnp.float32)
    y = xf * lax.rsqrt(jnp.mean(xf * xf, axis=-1, keepdims=True) + EPS) * g.astype(jnp.float32)
    return y.astype(x.dtype)


def causal_conv(x, buf, w, b):
    T = x.shape[1]
    xp = jnp.concatenate([buf.astype(x.dtype), x], axis=1)
    y = b.astype(x.dtype)
    for j in range(CONV_W):
        y = y + w[j].astype(x.dtype) * xp[:, j:j + T]
    return y, xp[:, -(CONV_W - 1):]


def rglru(xc, h0, w_a, b_a, w_x, b_x, lam):
    B, T, _ = xc.shape
    xf = xc.astype(jnp.float32)
    xh = xf.reshape(B, T, RNN_HEADS, RNN_HD)
    r = jax.nn.sigmoid(jnp.einsum('bthi,hij->bthj', xh, w_a.astype(jnp.float32)) + b_a).reshape(B, T, D_RNN)
    i = jax.nn.sigmoid(jnp.einsum('bthi,hij->bthj', xh, w_x.astype(jnp.float32)) + b_x).reshape(B, T, D_RNN)
    log_a = -LRU_C * r * jax.nn.softplus(-lam.astype(jnp.float32))
    a = jnp.exp(log_a)
    u = jnp.sqrt(-jnp.expm1(2.0 * log_a)) * (i * xf)

    def step(h, au):
        a_t, u_t = au
        h = a_t * h + u_t
        return h, h

    hT, hs = lax.scan(step, h0.astype(jnp.float32), (a.swapaxes(0, 1), u.swapaxes(0, 1)))
    return hs.swapaxes(0, 1), hT


def to_chunks(a, nc, L):
    B, H = a.shape[:2]
    return jnp.moveaxis(a.reshape(B, H, nc, L, *a.shape[3:]), 2, 0)


def mlstm_chunkwise(q, k, v, ig, lf, C0, n0, m0):
    B, H, T, Dh = q.shape
    L = CHUNK if T % CHUNK == 0 else T
    nc = T // L
    causal = jnp.tril(jnp.ones((L, L), dtype=bool))

    def step(carry, inp):
        C, n, m = carry
        qc, kc, vc, ic, fc = inp
        b = jnp.cumsum(fc, axis=-1)
        dmat = ic[..., None, :] + b[..., :, None] - b[..., None, :]
        dmat = jnp.where(causal, dmat, -jnp.inf)
        inter = b + m[..., None]
        m_t = jnp.maximum(inter, jnp.max(dmat, axis=-1))
        w_inter = jnp.exp(inter - m_t)
        s = jnp.einsum('bhtd,bhsd->bhts', qc, kc) * jnp.exp(dmat - m_t[..., None])
        num = w_inter[..., None] * jnp.einsum('bhvk,bhtk->bhtv', C, qc) + jnp.einsum('bhts,bhsv->bhtv', s, vc)
        den = w_inter * jnp.einsum('bhk,bhtk->bht', n, qc) + jnp.sum(s, axis=-1)
        h = num / jnp.maximum(jnp.abs(den), jnp.exp(-m_t))[..., None]
        m_new = m_t[..., -1]
        g_state = jnp.exp(b[..., -1] + m - m_new)
        g_in = jnp.exp(ic + b[..., -1:] - b - m_new[..., None])
        C_new = g_state[..., None, None] * C + jnp.einsum('bhs,bhsv,bhsk->bhvk', g_in, vc, kc)
        n_new = g_state[..., None] * n + jnp.einsum('bhs,bhsk->bhk', g_in, kc)
        return (C_new, n_new, m_new), h

    xs = (to_chunks(q, nc, L), to_chunks(k, nc, L), to_chunks(v, nc, L), to_chunks(ig, nc, L), to_chunks(lf, nc, L))
    init = (C0.astype(jnp.float32), n0.astype(jnp.float32), m0.astype(jnp.float32))
    (C, n, m), hs = lax.scan(step, init, xs)
    hs = jnp.moveaxis(hs, 0, 2).reshape(B, H, T, Dh)
    return hs, C, n, m


def mixer(h, rg_h, rg_conv, C, n, m, ml_conv, w):
    B, T, _ = h.shape
    z = h @ w['w_in']
    xr = z[..., OFF_RX:OFF_RG]
    gr = z[..., OFF_RG:OFF_MU]
    u = z[..., OFF_MU:OFF_MV]
    v = z[..., OFF_MV:OFF_MO]
    og = z[..., OFF_MO:OFF_MI]
    ig_pre = z[..., OFF_MI:OFF_MF]
    fg_pre = z[..., OFF_MF:D_IN]
    xc, rg_conv_new = causal_conv(xr, rg_conv, w['conv_rnn_w'], w['conv_rnn_b'])
    hs, rg_h_new = rglru(xc, rg_h, w['lru_wa'], w['lru_ba'], w['lru_wx'], w['lru_bx'], w['lru_lambda'])
    y_rnn = rmsnorm(hs * jax.nn.gelu(gr.astype(jnp.float32)), w['g_rnn_out'])
    uc, ml_conv_new = causal_conv(u, ml_conv, w['conv_ml_w'], w['conv_ml_b'])
    uc = jax.nn.silu(uc.astype(jnp.float32)).reshape(B, T, MLSTM_HEADS, MLSTM_HD)
    q = jnp.einsum('bthi,hij->bhtj', uc, w['ml_wq'].astype(jnp.float32))
    k = jnp.einsum('bthi,hij->bhtj', uc, w['ml_wk'].astype(jnp.float32)) * (MLSTM_HD ** -0.5)
    vv = v.astype(jnp.float32).reshape(B, T, MLSTM_HEADS, MLSTM_HD).transpose(0, 2, 1, 3)
    ig = (ig_pre.astype(jnp.float32) + w['ml_bi']).transpose(0, 2, 1)
    lf = jax.nn.log_sigmoid(fg_pre.astype(jnp.float32) + w['ml_bf']).transpose(0, 2, 1)
    hm, C_new, n_new, m_new = mlstm_chunkwise(q, k, vv, ig, lf, C, n, m)
    hm = hm.transpose(0, 2, 1, 3)
    o = jax.nn.sigmoid(og.astype(jnp.float32)).reshape(B, T, MLSTM_HEADS, MLSTM_HD)
    y_ml = (rmsnorm(hm, w['g_ml_out']) * o).reshape(B, T, D_MLSTM)
    y = jnp.concatenate([y_rnn, y_ml], axis=-1).astype(h.dtype) @ w['w_out']
    new = (rg_h_new.astype(rg_h.dtype), rg_conv_new.astype(rg_conv.dtype), C_new.astype(C.dtype),
           n_new.astype(n.dtype), m_new.astype(m.dtype), ml_conv_new.astype(ml_conv.dtype))
    return y, new


def mem_kv(mem, w):
    B = mem.shape[0]
    mn = rmsnorm(mem, w['g_mem'])
    mk = (mn @ w['w_mk']).reshape(B, N_MEM, X_HEADS, X_HD)
    mv = (mn @ w['w_mv']).reshape(B, N_MEM, X_HEADS, X_HD)
    return mk, mv


def cross_attn(h, mk, mv, w):
    B, T, _ = h.shape
    q = (h @ w['w_cq']).reshape(B, T, X_HEADS, X_HD)
    s = jnp.einsum('bthd,bnhd->bhtn', q, mk.astype(q.dtype)).astype(jnp.float32) * (X_HD ** -0.5)
    p = jax.nn.softmax(s, axis=-1)
    o = jnp.einsum('bhtn,bnhd->bthd', p.astype(h.dtype), mv.astype(h.dtype)).reshape(B, T, D_MODEL)
    return o @ w['w_co']


def block(x, rg_h, rg_conv, C, n, m, ml_conv, mk, mv, w):
    y, new = mixer(rmsnorm(x, w['g_mix']), rg_h, rg_conv, C, n, m, ml_conv, w)
    x = x + y.astype(x.dtype)
    x = x + cross_attn(rmsnorm(x, w['g_xattn']), mk, mv, w).astype(x.dtype)
    hf = rmsnorm(x, w['g_ffn'])
    x = x + (jnp.square(jax.nn.relu(hf @ w['w_up'])) @ w['w_down']).astype(x.dtype)
    return x, new


def setup_inputs(seed: int = 0) -> dict:
    key = jax.random.key(seed)
    ks = iter(jax.random.split(key, 64))

    def nrm(shape, scale=1.0):
        return jax.random.normal(next(ks), shape, jnp.float32) * scale

    def gain(shape):
        return 1.0 + nrm(shape, 0.01)

    Dp = DEPTH
    lam_a = jax.random.uniform(next(ks), (Dp, D_RNN), jnp.float32, 0.9, 0.999)
    return {
        'x_prompt': nrm((BATCH, SEQ, D_MODEL)),
        'x_sample': nrm((DEC_BATCH, DEC_SEQ, D_MODEL)),
        'mem_prompt': nrm((BATCH, N_MEM, D_MODEL)),
        'state_rglru_h': nrm((Dp, DEC_BATCH, D_RNN), 0.5),
        'state_rglru_conv': nrm((Dp, DEC_BATCH, CONV_W - 1, D_RNN)),
        'state_mlstm_C': nrm((Dp, DEC_BATCH, MLSTM_HEADS, MLSTM_HD, MLSTM_HD), 0.1),
        'state_mlstm_n': nrm((Dp, DEC_BATCH, MLSTM_HEADS, MLSTM_HD), 0.1),
        'state_mlstm_m': nrm((Dp, DEC_BATCH, MLSTM_HEADS)),
        'state_mlstm_conv': nrm((Dp, DEC_BATCH, CONV_W - 1, D_MLSTM)),
        'cache_mem_k': nrm((Dp, DEC_BATCH, N_MEM, X_HEADS, X_HD)),
        'cache_mem_v': nrm((Dp, DEC_BATCH, N_MEM, X_HEADS, X_HD)),
        'g_mix': gain((Dp, D_MODEL)),
        'w_in': nrm((Dp, D_MODEL, D_IN), D_MODEL ** -0.5),
        'conv_rnn_w': nrm((Dp, CONV_W, D_RNN), CONV_W ** -0.5),
        'conv_rnn_b': nrm((Dp, D_RNN), 0.01),
        'lru_wa': nrm((Dp, RNN_HEADS, RNN_HD, RNN_HD), RNN_HD ** -0.5),
        'lru_ba': nrm((Dp, RNN_HEADS, RNN_HD), 0.01),
        'lru_wx': nrm((Dp, RNN_HEADS, RNN_HD, RNN_HD), RNN_HD ** -0.5),
        'lru_bx': nrm((Dp, RNN_HEADS, RNN_HD), 0.01),
        'lru_lambda': jnp.log(lam_a) - jnp.log1p(-lam_a),
        'g_rnn_out': gain((Dp, D_RNN)),
        'conv_ml_w': nrm((Dp, CONV_W, D_MLSTM), CONV_W ** -0.5),
        'conv_ml_b': nrm((Dp, D_MLSTM), 0.01),
        'ml_wq': nrm((Dp, MLSTM_HEADS, MLSTM_HD, MLSTM_HD), MLSTM_HD ** -0.5),
        'ml_wk': nrm((Dp, MLSTM_HEADS, MLSTM_HD, MLSTM_HD), MLSTM_HD ** -0.5),
        'ml_bi': nrm((Dp, MLSTM_HEADS), 0.1),
        'ml_bf': jnp.linspace(3.0, 6.0, MLSTM_HEADS, dtype=jnp.float32)[None, :] + nrm((Dp, MLSTM_HEADS), 0.1),
        'g_ml_out': gain((Dp, MLSTM_HD)),
        'w_out': nrm((Dp, D_MODEL, D_MODEL), D_MODEL ** -0.5),
        'g_xattn': gain((Dp, D_MODEL)),
        'g_mem': gain((Dp, D_MODEL)),
        'w_cq': nrm((Dp, D_MODEL, D_MODEL), D_MODEL ** -0.5),
        'w_mk': nrm((Dp, D_MODEL, D_MODEL), D_MODEL ** -0.5),
        'w_mv': nrm((Dp, D_MODEL, D_MODEL), D_MODEL ** -0.5),
        'w_co': nrm((Dp, D_MODEL, D_MODEL), D_MODEL ** -0.5),
        'g_ffn': gain((Dp, D_MODEL)),
        'w_up': nrm((Dp, D_MODEL, D_FF), D_MODEL ** -0.5),
        'w_down': nrm((Dp, D_FF, D_MODEL), D_FF ** -0.5),
        'g_final': gain((D_MODEL,)),
    }


def reference(x_prompt, x_sample, mem_prompt, state_rglru_h, state_rglru_conv, state_mlstm_C,
              state_mlstm_n, state_mlstm_m, state_mlstm_conv, cache_mem_k, cache_mem_v,
              g_mix, w_in, conv_rnn_w, conv_rnn_b, lru_wa, lru_ba, lru_wx, lru_bx, lru_lambda,
              g_rnn_out, conv_ml_w, conv_ml_b, ml_wq, ml_wk, ml_bi, ml_bf, g_ml_out, w_out,
              g_xattn, g_mem, w_cq, w_mk, w_mv, w_co, g_ffn, w_up, w_down, g_final):
    B = x_prompt.shape[0]
    dt = x_prompt.dtype
    xp, xs = x_prompt, x_sample
    p_out = [[] for _ in range(8)]
    s_out = [[] for _ in range(6)]
    for l in range(DEPTH):
        w = dict(g_mix=g_mix[l], w_in=w_in[l], conv_rnn_w=conv_rnn_w[l], conv_rnn_b=conv_rnn_b[l],
                 lru_wa=lru_wa[l], lru_ba=lru_ba[l], lru_wx=lru_wx[l], lru_bx=lru_bx[l],
                 lru_lambda=lru_lambda[l], g_rnn_out=g_rnn_out[l], conv_ml_w=conv_ml_w[l],
                 conv_ml_b=conv_ml_b[l], ml_wq=ml_wq[l], ml_wk=ml_wk[l], ml_bi=ml_bi[l], ml_bf=ml_bf[l],
                 g_ml_out=g_ml_out[l], w_out=w_out[l], g_xattn=g_xattn[l], g_mem=g_mem[l],
                 w_cq=w_cq[l], w_mk=w_mk[l], w_mv=w_mv[l], w_co=w_co[l], g_ffn=g_ffn[l],
                 w_up=w_up[l], w_down=w_down[l])
        z_h = jnp.zeros((B, D_RNN), dt)
        z_rc = jnp.zeros((B, CONV_W - 1, D_RNN), dt)
        z_C = jnp.zeros((B, MLSTM_HEADS, MLSTM_HD, MLSTM_HD), dt)
        z_n = jnp.zeros((B, MLSTM_HEADS, MLSTM_HD), dt)
        z_m = jnp.zeros((B, MLSTM_HEADS), dt)
        z_mc = jnp.zeros((B, CONV_W - 1, D_MLSTM), dt)
        mk_p, mv_p = mem_kv(mem_prompt, w)
        xp, new_p = block(xp, z_h, z_rc, z_C, z_n, z_m, z_mc, mk_p, mv_p, w)
        for j, a in enumerate(new_p):
            p_out[j].append(a)
        p_out[6].append(mk_p)
        p_out[7].append(mv_p)
        xs, new_s = block(xs, state_rglru_h[l], state_rglru_conv[l], state_mlstm_C[l], state_mlstm_n[l],
                          state_mlstm_m[l], state_mlstm_conv[l], cache_mem_k[l], cache_mem_v[l], w)
        for j, a in enumerate(new_s):
            s_out[j].append(a)
    y_prompt = rmsnorm(xp, g_final)
    y_sample = rmsnorm(xs, g_final)
    P = [jnp.stack(a, axis=0) for a in p_out]
    S = [jnp.stack(a, axis=0) for a in s_out]
    return (y_prompt, y_sample, P[0], P[1], P[2], P[3], P[4], P[5], P[6], P[7],
            S[0], S[1], S[2], S[3], S[4], S[5])
```

```cpp
#include <hip/hip_runtime.h>
#include <cstdio>
#include <cstdint>

#define LAS __attribute__((address_space(3)))
typedef unsigned short bf16_t;
typedef short bf16x8 __attribute__((ext_vector_type(8)));
typedef short s16x4 __attribute__((ext_vector_type(4)));
typedef float f32x4 __attribute__((ext_vector_type(4)));
typedef float f32x2 __attribute__((ext_vector_type(2)));
typedef unsigned u32x4 __attribute__((ext_vector_type(4)));
typedef unsigned u32x2 __attribute__((ext_vector_type(2)));

constexpr int D = 2048, NB = 4, TT = 2048, MP = NB * TT, MS = 128, MT = MP + MS;
constexpr int DIN = 5128, NZ = 5120, NZP = 5376, DR = 1024, DFF = 8192, NMEM = 256, MMEM = NB * NMEM;
constexpr float EPS = 1e-6f;
constexpr int OFF_RX = 0, OFF_RG = 1024, OFF_MU = 2048, OFF_MV = 3072, OFF_MO = 4096;
constexpr size_t O_YP = 0;
constexpr size_t O_YS = O_YP + (size_t)MP * D;
constexpr size_t O_PH = O_YS + (size_t)MS * D;
constexpr size_t O_PRC = O_PH + 4 * 1024;
constexpr size_t O_PC = O_PRC + 4 * 3 * 1024;
constexpr size_t O_PN = O_PC + (size_t)4 * 4 * 65536;
constexpr size_t O_PM = O_PN + 4 * 4 * 256;
constexpr size_t O_PMC = O_PM + 16;
constexpr size_t O_PK = O_PMC + 4 * 3 * 1024;
constexpr size_t O_PV = O_PK + (size_t)MMEM * D;
constexpr size_t O_SH = O_PV + (size_t)MMEM * D;
constexpr size_t O_SRC = O_SH + 128 * 1024;
constexpr size_t O_SC = O_SRC + 128 * 3 * 1024;
constexpr size_t O_SN = O_SC + (size_t)128 * 4 * 65536;
constexpr size_t O_SM = O_SN + 128 * 4 * 256;
constexpr size_t O_SMC = O_SM + 512;
constexpr size_t MiB = 1u << 20;
constexpr size_t WS_WIN = 0, WS_WOUT = 20 * MiB, WS_WCQ = 28 * MiB, WS_WMK = 36 * MiB, WS_WMV = 44 * MiB, WS_WCO = 52 * MiB;
constexpr size_t WS_WUP = 60 * MiB, WS_WDN = 92 * MiB, WS_WG = 124 * MiB, WS_WQK = 125 * MiB, WS_XN = 126 * MiB, WS_MN = 159 * MiB;
constexpr size_t WS_Z = 163 * MiB, WS_GATES = 245 * MiB, WS_XC = 246 * MiB, WS_UC = 263 * MiB, WS_AU = 280 * MiB, WS_QM = 345 * MiB;
constexpr size_t WS_KM = 362 * MiB, WS_Y = 379 * MiB, WS_X1 = 412 * MiB, WS_X2 = 477 * MiB, WS_QC = 542 * MiB, WS_OC = 575 * MiB;
constexpr size_t WS_MK = 608 * MiB, WS_MVT = 612 * MiB, WS_U = 616 * MiB, WS_CLOC = 746 * MiB, WS_CIN = 778 * MiB, WS_NLOC = 810 * MiB;
constexpr size_t WS_NIN = 811 * MiB, WS_MSTAT = 812 * MiB, WS_SUM = 813 * MiB, WS_PART = 815 * MiB, WS_CTL = 819 * MiB, WS_WIN2 = 820 * MiB, WS_END = 842 * MiB;
constexpr int LDS_BYTES = 147712, MISC_OFF = 139264;
constexpr int NPH = 16;

__device__ __forceinline__ unsigned f2bf(float f) { unsigned u = __builtin_bit_cast(unsigned, f); return (u + 0x7fffu + ((u >> 16) & 1u)) >> 16; }
__device__ __forceinline__ unsigned pk2(float lo, float hi) { return f2bf(lo) | (f2bf(hi) << 16); }
__device__ __forceinline__ float bf2f(unsigned h) { return __builtin_bit_cast(float, (h & 0xffffu) << 16); }
__device__ __forceinline__ float bflo(unsigned w) { return __builtin_bit_cast(float, w << 16); }
__device__ __forceinline__ float bfhi(unsigned w) { return __builtin_bit_cast(float, w & 0xffff0000u); }
__device__ __forceinline__ float wave_sum(float v) {
#pragma unroll
    for (int o = 1; o < 64; o <<= 1) v += __shfl_xor(v, o);
    return v;
}
__device__ __forceinline__ float wave_max(float v) {
#pragma unroll
    for (int o = 1; o < 64; o <<= 1) v = fmaxf(v, __shfl_xor(v, o));
    return v;
}
__device__ __forceinline__ void reduce32(float (&a)[32], int lane) {
#pragma unroll
    for (int i = 0; i < 16; ++i) { const bool up = lane & 32; const float keep = up ? a[i + 16] : a[i], send = up ? a[i] : a[i + 16]; a[i] = keep + __shfl_xor(send, 32); }
#pragma unroll
    for (int i = 0; i < 8; ++i) { const bool up = lane & 16; const float keep = up ? a[i + 8] : a[i], send = up ? a[i] : a[i + 8]; a[i] = keep + __shfl_xor(send, 16); }
#pragma unroll
    for (int i = 0; i < 4; ++i) { const bool up = lane & 8; const float keep = up ? a[i + 4] : a[i], send = up ? a[i] : a[i + 4]; a[i] = keep + __shfl_xor(send, 8); }
#pragma unroll
    for (int i = 0; i < 2; ++i) { const bool up = lane & 4; const float keep = up ? a[i + 2] : a[i], send = up ? a[i] : a[i + 2]; a[i] = keep + __shfl_xor(send, 4); }
    { const bool up = lane & 2; const float keep = up ? a[1] : a[0], send = up ? a[0] : a[1]; a[0] = keep + __shfl_xor(send, 2); }
    a[0] += __shfl_xor(a[0], 1);
}
__device__ __forceinline__ float sigmoidf_(float x) { return 1.f / (1.f + __expf(-x)); }
__device__ __forceinline__ float gelu_tanh(float x) { const float u = 0.7978845608028654f * (x + 0.044715f * x * x * x); return 0.5f * x * (1.f + tanhf(u)); }
__device__ __forceinline__ float logsigmoid_(float x) { return fminf(x, 0.f) - log1pf(__expf(-fabsf(x))); }
__device__ __forceinline__ bf16x8 ld8(const bf16_t* p) { return *(const bf16x8*)p; }
__device__ __forceinline__ s16x4 tr_read(const LAS unsigned char* p) {
    typedef short v4i16_t __attribute__((ext_vector_type(4)));
    return __builtin_bit_cast(s16x4, __builtin_amdgcn_ds_read_tr16_b64_v4i16((LAS v4i16_t*)p));
}
__device__ __forceinline__ bf16x8 cat8(s16x4 a, s16x4 b) { return (bf16x8){a[0], a[1], a[2], a[3], b[0], b[1], b[2], b[3]}; }
__device__ __forceinline__ int lane_id() { int l; asm volatile("v_mbcnt_lo_u32_b32 %0, -1, 0\n\tv_mbcnt_hi_u32_b32 %0, -1, %0" : "=v"(l)); return l; }
#define MFMA16(x, y, c) __builtin_amdgcn_mfma_f32_16x16x32_bf16((x), (y), (c), 0, 0, 0)

namespace pg8 {
constexpr int BM = 256, BK = 64, HALF = 128, HTB = HALF * BK * 2, STAGE_BYTES = 8 * HTB, NXCD = 8, WGM = 8;
__host__ __device__ __forceinline__ int lds_byte(int r, int c) { const int st = (r >> 4) * 2 + (c >> 5), rr = r & 15, cc = c & 31, ob = rr * 64 + cc * 2; return st * 1024 + (ob ^ (((ob >> 9) & 1) << 5)); }
__host__ __device__ __forceinline__ void stage_rc(int b, int& R, int& C) { const int st = b / 1024, sb = b % 1024, swz = sb ^ (((sb >> 9) & 1) << 5); R = (st >> 1) * 16 + swz / 64; C = (st & 1) * 32 + (swz % 64) / 2; }
__host__ __device__ __forceinline__ int perm32(int rho) { const int n = rho >> 4, i = rho & 15; return 8 * (i >> 2) + 4 * n + (i & 3); }
struct Unit { int pm, pn; };
struct Gemm { const char* A; const char* B; int lda, ldb  , K; size_t a_pm; int a_sh; size_t a_pn, b_pn, b_pm8; int a_msk, b_msk, b_sh2; size_t b_pn2; };
__device__ __forceinline__ Gemm mk_gemm(const void* A, const void* B, int lda, int ldb, int K, int acs) { return Gemm{(const char*)A, (const char*)B, lda, ldb, K, (size_t)256 * lda, 1, (size_t)acs, (size_t)256 * ldb, 0, 0x7fffffff, 0x7fffffff, 0, 0}; }
struct StaticOrder {
    int nM, nN, nwg, G, c;
    __device__ void init(int nM_, int nN_, int G_, int c_) { nM = nM_; nN = nN_; nwg = nM * nN; G = G_; c = c_; }
    __device__ bool next(int i, Unit& u) const {
        if (c < 0 || c >= G) return false;
        const long L = (long)i * G + c; if (L >= nwg) return false;
        int wgid = (int)L; { const int q = nwg / NXCD, r = nwg % NXCD, xcd = wgid % NXCD, off = wgid / NXCD; wgid = (xcd < r ? xcd * (q + 1) : r * (q + 1) + (xcd - r) * q) + off; }
        const int nig = WGM * nN, gid = wgid / nig, fm = gid * WGM, gsz = (nM - fm) < WGM ? (nM - fm) : WGM;
        u.pm = fm + ((wgid % nig) % gsz); u.pn = (wgid % nig) / gsz; return true;
    }
};
template <class F> struct EpiF8 {
    static constexpr bool PERM = true;
    F f;
    __device__ __forceinline__ void operator()(const f32x4 (&acc)[2][2][4][2], const Unit& u, int wr, int wc, int fr, int fq) const {
        float rs[2][4];
#pragma unroll
        for (int ai = 0; ai < 2; ++ai)
#pragma unroll
            for (int m = 0; m < 4; ++m) rs[ai][m] = f.rowscale(u.pm * BM + ai * HALF + wr * 64 + m * 16 + fr);
#pragma unroll
        for (int ai = 0; ai < 2; ++ai)
#pragma unroll
            for (int m = 0; m < 4; ++m) {
                const int row = u.pm * BM + ai * HALF + wr * 64 + m * 16 + fr;
#pragma unroll
                for (int bj = 0; bj < 2; ++bj) f.f8(row, u.pn * BM + bj * HALF + wc * 32 + 8 * fq, acc[ai][bj][m][0] * rs[ai][m], acc[ai][bj][m][1] * rs[ai][m]);
            }
    }
};
template <class F> struct EpiF {
    static constexpr bool PERM = false;
    F f;
    __device__ __forceinline__ void operator()(const f32x4 (&acc)[2][2][4][2], const Unit& u, int wr, int wc, int fr, int fq) const {
        float rs[2][4];
#pragma unroll
        for (int ai = 0; ai < 2; ++ai)
#pragma unroll
            for (int m = 0; m < 4; ++m) rs[ai][m] = f.rowscale(u.pm * BM + ai * HALF + wr * 64 + m * 16 + fr);
#pragma unroll
        for (int ai = 0; ai < 2; ++ai)
#pragma unroll
            for (int m = 0; m < 4; ++m) {
                const int row = u.pm * BM + ai * HALF + wr * 64 + m * 16 + fr;
#pragma unroll
                for (int bj = 0; bj < 2; ++bj)
#pragma unroll
                    for (int n = 0; n < 2; ++n) f(row, u.pn * BM + bj * HALF + wc * 32 + n * 16 + 4 * fq, acc[ai][bj][m][n] * rs[ai][m]);
            }
    }
};

template <class Epi, bool ALIGN_EPI, bool SP2>
__device__ __forceinline__ void gemm_phase(LAS unsigned char* lds, const Gemm g, const StaticOrder& S, const Epi& E, const int wid) {
    const int lane = lane_id(), tid = wid * 64 + lane, wr = wid >> 2, wc = wid & 3, fr = lane & 15, fq = lane >> 4;
    const int K = g.K, nt = K / BK;
    unsigned voffA[2], voffB[2];
#pragma unroll
    for (int i = 0; i < 2; ++i) { int R, C; stage_rc(tid * 16 + i * 8192, R, C); const int Rb = Epi::PERM ? ((R & ~31) + perm32(R & 31)) : R; voffA[i] = (unsigned)(R * g.lda + C * 2); voffB[i] = (unsigned)(Rb * g.ldb + C * 2); }
    const size_t kstep = (size_t)(BK * 2);
    const size_t hstepA = (size_t)HALF * g.lda, hstepB = (size_t)HALF * g.ldb;
    const unsigned ldsw = (unsigned)wid * 1024u;
    const int aoff = lds_byte(wr * 64 + fr, fq * 8), boff = lds_byte(wc * 32 + fr, fq * 8);
#define PG8_SA(b, h) (((b) * 2 + (h)) * HTB)
#define PG8_SB(b, h) ((4 + (b) * 2 + (h)) * HTB)
#define PG8_STAGE(bufoff, gbase, voff) do { _Pragma("unroll") for (int _i = 0; _i < 2; ++_i) \
        __builtin_amdgcn_global_load_lds((const unsigned*)((const char*)(gbase) + (voff)[_i]), (LAS unsigned*)(lds + (bufoff) + ldsw + _i * 8192), 16, 0, 0); } while (0)
#define PG8_LDA(dst, b, h) do { _Pragma("unroll") for (int m = 0; m < 4; ++m) _Pragma("unroll") for (int k = 0; k < 2; ++k) dst[m][k] = *(const LAS bf16x8*)(lds + PG8_SA(b, h) + aoff + m * 2048 + k * 1024); } while (0)
#define PG8_LDB(dst, b, h) do { _Pragma("unroll") for (int n = 0; n < 2; ++n) _Pragma("unroll") for (int k = 0; k < 2; ++k) dst[n][k] = *(const LAS bf16x8*)(lds + PG8_SB(b, h) + boff + n * 2048 + k * 1024); } while (0)
#define PG8_MMA(ai, bj, At, Bt) do { __builtin_amdgcn_s_setprio(1); _Pragma("unroll") for (int m = 0; m < 4; ++m) _Pragma("unroll") for (int n = 0; n < 2; ++n) _Pragma("unroll") for (int k = 0; k < 2; ++k) \
        acc[ai][bj][m][n] = __builtin_amdgcn_mfma_f32_16x16x32_bf16(Bt[n][k], At[m][k], acc[ai][bj][m][n], 0, 0, 0); __builtin_amdgcn_s_setprio(0); } while (0)
#define PG8_WAIT_V(n) asm volatile("s_waitcnt vmcnt(" #n ")" ::: "memory")
#define PG8_WAIT_L(n) asm volatile("s_waitcnt lgkmcnt(" #n ")" ::: "memory")
#define PG8_BAR __builtin_amdgcn_s_barrier()
#define PG8_SCHED __builtin_amdgcn_sched_barrier(0)
#define PG8_APTR(u) (g.A + (size_t)(u).pm * g.a_pm + (size_t)(((u).pn >> g.a_sh) & g.a_msk) * g.a_pn)
#define PG8_BPTR(u) (g.B + (size_t)((u).pn & g.b_msk) * g.b_pn + (size_t)((u).pn >> g.b_sh2) * g.b_pn2 + (size_t)((u).pm >> 3) * g.b_pm8)
    Unit cur, nxt; int ui = 0;
    if (!S.next(0, cur)) return;
    f32x4 acc[2][2][4][2];
#pragma unroll
    for (int a = 0; a < 2; ++a)
#pragma unroll
        for (int b = 0; b < 2; ++b)
#pragma unroll
            for (int m = 0; m < 4; ++m)
#pragma unroll
                for (int n = 0; n < 2; ++n) acc[a][b][m][n] = (f32x4){0.f, 0.f, 0.f, 0.f};
    bf16x8 At[4][2], B0[2][2], B1[2][2];
    const char* cA = PG8_APTR(cur); const char* cB = PG8_BPTR(cur);
    if constexpr (SP2) {
        PG8_STAGE(PG8_SB(0, 0), cB, voffB); PG8_STAGE(PG8_SB(0, 1), cB + hstepB, voffB); PG8_STAGE(PG8_SA(0, 0), cA, voffA); PG8_STAGE(PG8_SA(0, 1), cA + hstepA, voffA);
        if (wr == 1) PG8_BAR;
        PG8_WAIT_V(2); PG8_BAR;
        PG8_STAGE(PG8_SB(1, 0), cB + kstep, voffB); PG8_STAGE(PG8_SA(1, 0), cA + kstep, voffA); PG8_STAGE(PG8_SB(1, 1), cB + hstepB + kstep, voffB);
        PG8_WAIT_V(6); PG8_BAR;
    } else {
        PG8_STAGE(PG8_SB(0, 0), cB, voffB); PG8_STAGE(PG8_SA(0, 0), cA, voffA); PG8_STAGE(PG8_SB(0, 1), cB + hstepB, voffB); PG8_STAGE(PG8_SA(0, 1), cA + hstepA, voffA);
        if (wr == 1) PG8_BAR;
        PG8_WAIT_V(4); PG8_BAR;
        PG8_STAGE(PG8_SB(1, 0), cB + kstep, voffB); PG8_STAGE(PG8_SA(1, 0), cA + kstep, voffA); PG8_STAGE(PG8_SB(1, 1), cB + hstepB + kstep, voffB);
        PG8_WAIT_V(6); PG8_BAR;
    }
    for (;;) {
        const bool has_next = S.next(ui + 1, nxt);
        const char* nA = has_next ? PG8_APTR(nxt) : cA; const char* nB = has_next ? PG8_BPTR(nxt) : cB;
#pragma nounroll
        for (int t = 0; t < nt; t += 2) {
            const bool last = (t == nt - 2);
            const char* a1 = cA + (size_t)(t + 1) * kstep;
            const char* a2 = last ? nA : cA + (size_t)(t + 2) * kstep; const char* b2 = last ? nB : cB + (size_t)(t + 2) * kstep;
            const char* a3 = a2 + kstep; const char* b3 = b2 + kstep;
            if constexpr (SP2) {
            PG8_LDB(B0, 0, 0); PG8_LDB(B1, 0, 1); PG8_SCHED; PG8_LDA(At, 0, 0); PG8_STAGE(PG8_SA(1, 1), a1 + hstepA, voffA);
            PG8_WAIT_V(8); PG8_WAIT_L(0); PG8_BAR; PG8_MMA(0, 0, At, B0); PG8_MMA(0, 1, At, B1); PG8_BAR; PG8_SCHED;
            PG8_LDA(At, 0, 1); PG8_STAGE(PG8_SB(0, 0), b2, voffB); PG8_STAGE(PG8_SB(0, 1), b2 + hstepB, voffB); PG8_STAGE(PG8_SA(0, 0), a2, voffA);
            PG8_WAIT_V(8); PG8_WAIT_L(0); PG8_BAR; PG8_MMA(1, 0, At, B0); PG8_MMA(1, 1, At, B1); PG8_BAR; PG8_SCHED;
            PG8_LDB(B0, 1, 0); PG8_LDB(B1, 1, 1); PG8_SCHED; PG8_LDA(At, 1, 0); PG8_STAGE(PG8_SA(0, 1), a2 + hstepA, voffA);
            PG8_WAIT_V(8); PG8_WAIT_L(0); PG8_BAR; PG8_MMA(0, 0, At, B0); PG8_MMA(0, 1, At, B1); PG8_BAR; PG8_SCHED;
            PG8_LDA(At, 1, 1); PG8_STAGE(PG8_SB(1, 0), b3, voffB); PG8_STAGE(PG8_SB(1, 1), b3 + hstepB, voffB); PG8_STAGE(PG8_SA(1, 0), a3, voffA);
            PG8_WAIT_V(8); PG8_WAIT_L(0); PG8_BAR; PG8_MMA(1, 0, At, B0); PG8_MMA(1, 1, At, B1); PG8_BAR; PG8_SCHED;
            } else {
            PG8_LDB(B0, 0, 0); PG8_SCHED; PG8_LDA(At, 0, 0); PG8_STAGE(PG8_SA(1, 1), a1 + hstepA, voffA);
            PG8_WAIT_L(8); PG8_BAR; PG8_WAIT_L(0); PG8_MMA(0, 0, At, B0); PG8_BAR; PG8_SCHED;
            PG8_LDB(B1, 0, 1); PG8_STAGE(PG8_SB(0, 0), b2, voffB);
            PG8_BAR; PG8_WAIT_L(0); PG8_MMA(0, 1, At, B1); PG8_BAR;
            PG8_LDA(At, 0, 1); PG8_STAGE(PG8_SA(0, 0), a2, voffA);
            PG8_BAR; PG8_WAIT_L(0); PG8_MMA(1, 0, At, B0); PG8_BAR; PG8_SCHED;
            PG8_STAGE(PG8_SB(0, 1), b2 + hstepB, voffB);
            PG8_WAIT_V(6); PG8_BAR; PG8_MMA(1, 1, At, B1); PG8_BAR;
            PG8_LDB(B0, 1, 0); PG8_SCHED; PG8_LDA(At, 1, 0); PG8_STAGE(PG8_SA(0, 1), a2 + hstepA, voffA);
            PG8_WAIT_L(8); PG8_BAR; PG8_WAIT_L(0); PG8_MMA(0, 0, At, B0); PG8_BAR; PG8_SCHED;
            PG8_LDB(B1, 1, 1); PG8_STAGE(PG8_SB(1, 0), b3, voffB);
            PG8_BAR; PG8_WAIT_L(0); PG8_MMA(0, 1, At, B1); PG8_BAR;
            PG8_LDA(At, 1, 1); PG8_STAGE(PG8_SA(1, 0), a3, voffA);
            PG8_BAR; PG8_WAIT_L(0); PG8_MMA(1, 0, At, B0); PG8_BAR; PG8_SCHED;
            PG8_STAGE(PG8_SB(1, 1), b3 + hstepB, voffB);
            PG8_WAIT_V(6); PG8_BAR; PG8_MMA(1, 1, At, B1); PG8_BAR;
            }
        }
        if constexpr (ALIGN_EPI) { if (wr == 0) PG8_BAR; }
        E(acc, cur, wr, wc, fr, fq);
        if (!has_next) break;
#pragma unroll
        for (int a = 0; a < 2; ++a)
#pragma unroll
            for (int b = 0; b < 2; ++b)
#pragma unroll
                for (int m = 0; m < 4; ++m)
#pragma unroll
                    for (int n = 0; n < 2; ++n) acc[a][b][m][n] = (f32x4){0.f, 0.f, 0.f, 0.f};
        cur = nxt; cA = nA; cB = nB; ++ui;
        if constexpr (ALIGN_EPI) { if (wr == 1) PG8_BAR; }
    }
    PG8_WAIT_V(0);
    if constexpr (!ALIGN_EPI) { if (wr == 0) PG8_BAR; }
    PG8_BAR;
#undef PG8_SA
#undef PG8_SB
#undef PG8_STAGE
#undef PG8_LDA
#undef PG8_LDB
#undef PG8_MMA
#undef PG8_WAIT_V
#undef PG8_WAIT_L
#undef PG8_BAR
#undef PG8_SCHED
#undef PG8_APTR
#undef PG8_BPTR
}
}

struct FStoreBf16 { bf16_t* O; int ld; float scale; int act; const float* ss;
    __device__ __forceinline__ float rowscale(int row) const { return ss ? scale * rsqrtf(ss[row] * (1.f / D) + EPS) : scale; }
    __device__ __forceinline__ void operator()(int row, int col, f32x4 v) const {
        if (act == 1) {
#pragma unroll
            for (int e = 0; e < 4; ++e) { const float r = fmaxf(v[e], 0.f); v[e] = r * r; }
        }
        u32x2 w; w.x = pk2(v[0], v[1]); w.y = pk2(v[2], v[3]); *(u32x2*)(O + (size_t)row * ld + col) = w; }
    __device__ __forceinline__ void f8(int row, int col, f32x4 a, f32x4 b) const {
        if (act == 1) {
#pragma unroll
            for (int e = 0; e < 4; ++e) { const float r = fmaxf(a[e], 0.f); a[e] = r * r; const float s = fmaxf(b[e], 0.f); b[e] = s * s; }
        }
        u32x4 w; w.x = pk2(a[0], a[1]); w.y = pk2(a[2], a[3]); w.z = pk2(b[0], b[1]); w.w = pk2(b[2], b[3]); *(u32x4*)(O + (size_t)row * ld + col) = w; } };
struct FResF32 { const float* base; int brow0; float* out; int ld;
    __device__ __forceinline__ float rowscale(int) const { return 1.f; }
    __device__ __forceinline__ void operator()(int row, int col, f32x4 v) const {
        const f32x4 b = *(const f32x4*)(base + (size_t)(row - brow0) * ld + col); *(f32x4*)(out + (size_t)row * ld + col) = b + v; } };
struct FZ { bf16_t* Zp; float* Gp;
    __device__ __forceinline__ float rowscale(int) const { return 1.f; }
    __device__ __forceinline__ void operator()(int row, int col, f32x4 v) const {
        if (row >= MT) return;
        if (col < NZ) { u32x2 w; w.x = pk2(v[0], v[1]); w.y = pk2(v[2], v[3]); *(u32x2*)(Zp + (size_t)row * NZ + col) = w; }
        else if (col < NZ + 8) *(f32x4*)(Gp + (size_t)row * 8 + (col - NZ)) = v; }
    __device__ __forceinline__ void f8(int row, int col, f32x4 a, f32x4 b) const {
        if (row >= MT) return;
        if (col < NZ) { u32x4 w; w.x = pk2(a[0], a[1]); w.y = pk2(a[2], a[3]); w.z = pk2(b[0], b[1]); w.w = pk2(b[2], b[3]); *(u32x4*)(Zp + (size_t)row * NZ + col) = w; }
        else if (col == NZ) { *(f32x4*)(Gp + (size_t)row * 8) = a; *(f32x4*)(Gp + (size_t)row * 8 + 4) = b; } } };
__device__ __forceinline__ f32x4 ld4_res(const float* p) { return __builtin_nontemporal_load((const f32x4*)p); }
__device__ __forceinline__ f32x4 ld4_res(const bf16_t* p) { const u32x2 w = *(const u32x2*)p; return (f32x4){bflo(w.x), bfhi(w.x), bflo(w.y), bfhi(w.y)}; }
template <class BT> struct FResNorm { const BT* base; int brow0; bf16_t* out; bf16_t* xn; const float* g; float* ssq;
    __device__ __forceinline__ float rowscale(int) const { return 1.f; }
    __device__ __forceinline__ void operator()(int row, int col, f32x4 v) const {
        const f32x4 x = ld4_res(base + (size_t)(row - brow0) * D + col) + v;
        u32x2 o; o.x = pk2(x[0], x[1]); o.y = pk2(x[2], x[3]); *(u32x2*)(out + (size_t)row * D + col) = o;
        const f32x4 gg = *(const f32x4*)(g + col); u32x2 w; w.x = pk2(x[0] * gg[0], x[1] * gg[1]); w.y = pk2(x[2] * gg[2], x[3] * gg[3]); *(u32x2*)(xn + (size_t)row * D + col) = w;
        atomicAdd(ssq + row, (x[0] * x[0] + x[1] * x[1]) + (x[2] * x[2] + x[3] * x[3])); } };
template <class BT> struct EpiResNorm { static constexpr bool PERM = true; const BT* base; bf16_t* out; bf16_t* xn; const float* g; float* ssq;
    __device__ __forceinline__ void operator()(const f32x4 (&acc)[2][2][4][2], const pg8::Unit& u, int wr, int wc, int fr, int fq) const {
        f32x4 gg[2][2];
#pragma unroll
        for (int bj = 0; bj < 2; ++bj) { const int col = u.pn * 256 + bj * 128 + wc * 32 + 8 * fq; gg[bj][0] = *(const f32x4*)(g + col); gg[bj][1] = *(const f32x4*)(g + col + 4); }
#pragma unroll
        for (int ai = 0; ai < 2; ++ai)
#pragma unroll
            for (int m = 0; m < 4; ++m) {
                const int row = u.pm * 256 + ai * 128 + wr * 64 + m * 16 + fr; float ss = 0.f;
#pragma unroll
                for (int bj = 0; bj < 2; ++bj) { const size_t o = (size_t)row * D + u.pn * 256 + bj * 128 + wc * 32 + 8 * fq;
                    const f32x4 x0 = ld4_res(base + o) + acc[ai][bj][m][0], x1 = ld4_res(base + o + 4) + acc[ai][bj][m][1];
                    u32x4 w; w.x = pk2(x0[0], x0[1]); w.y = pk2(x0[2], x0[3]); w.z = pk2(x1[0], x1[1]); w.w = pk2(x1[2], x1[3]); *(u32x4*)(out + o) = w;
                    const f32x4 y0 = x0 * gg[bj][0], y1 = x1 * gg[bj][1];
                    u32x4 z; z.x = pk2(y0[0], y0[1]); z.y = pk2(y0[2], y0[3]); z.z = pk2(y1[0], y1[1]); z.w = pk2(y1[2], y1[3]); *(u32x4*)(xn + o) = z;
                    ss += ((x0[0] * x0[0] + x0[1] * x0[1]) + (x0[2] * x0[2] + x0[3] * x0[3])) + ((x1[0] * x1[0] + x1[1] * x1[1]) + (x1[2] * x1[2] + x1[3] * x1[3])); }
                ss += __shfl_xor(ss, 16); ss += __shfl_xor(ss, 32);
                if (fq == 0) atomicAdd(ssq + row, ss);
                if (m & 1) asm volatile("" ::: "memory");
            }
    } };
struct FResB { const bf16_t* base; bf16_t* out;
    __device__ __forceinline__ float rowscale(int) const { return 1.f; }
    __device__ __forceinline__ void f8(int row, int col, f32x4 a, f32x4 b) const {
        const size_t o = (size_t)row * D + col; const f32x4 x0 = ld4_res(base + o) + a, x1 = ld4_res(base + o + 4) + b;
        u32x4 w; w.x = pk2(x0[0], x0[1]); w.y = pk2(x0[2], x0[3]); w.z = pk2(x1[0], x1[1]); w.w = pk2(x1[2], x1[3]); *(u32x4*)(out + o) = w; } };
struct EpiSoftmax { static constexpr bool PERM = true; bf16_t* P; LAS float* xch;
    __device__ __forceinline__ void operator()(f32x4 (&acc)[2][2][4][2], const pg8::Unit& u, int wr, int wc, int fr, int fq) const {
        float mx[2][4];
#pragma unroll
        for (int ai = 0; ai < 2; ++ai)
#pragma unroll
            for (int m = 0; m < 4; ++m) {
                float v = -INFINITY;
#pragma unroll
                for (int bj = 0; bj < 2; ++bj)
#pragma unroll
                    for (int n = 0; n < 2; ++n) v = fmaxf(v, fmaxf(fmaxf(acc[ai][bj][m][n][0], acc[ai][bj][m][n][1]), fmaxf(acc[ai][bj][m][n][2], acc[ai][bj][m][n][3])));
                v = fmaxf(v, __shfl_xor(v, 16)); v = fmaxf(v, __shfl_xor(v, 32));
                if (fq == 0) xch[(ai * 128 + wr * 64 + m * 16 + fr) * 4 + wc] = v;
            }
        asm volatile("s_waitcnt lgkmcnt(0)" ::: "memory"); __builtin_amdgcn_s_barrier(); asm volatile("" ::: "memory");
#pragma unroll
        for (int ai = 0; ai < 2; ++ai)
#pragma unroll
            for (int m = 0; m < 4; ++m) {
                const f32x4 t = *(const LAS f32x4*)(xch + (ai * 128 + wr * 64 + m * 16 + fr) * 4);
                mx[ai][m] = fmaxf(fmaxf(t[0], t[1]), fmaxf(t[2], t[3]));
                float s = 0.f;
#pragma unroll
                for (int bj = 0; bj < 2; ++bj)
#pragma unroll
                    for (int n = 0; n < 2; ++n)
#pragma unroll
                        for (int e = 0; e < 4; ++e) { const float p = __expf(acc[ai][bj][m][n][e] - mx[ai][m]); acc[ai][bj][m][n][e] = p; s += p; }
                s += __shfl_xor(s, 16); s += __shfl_xor(s, 32);
                if (fq == 0) xch[1024 + (ai * 128 + wr * 64 + m * 16 + fr) * 4 + wc] = s;
            }
        asm volatile("s_waitcnt lgkmcnt(0)" ::: "memory"); __builtin_amdgcn_s_barrier(); asm volatile("" ::: "memory");
#pragma unroll
        for (int ai = 0; ai < 2; ++ai)
#pragma unroll
            for (int m = 0; m < 4; ++m) {
                const f32x4 t = *(const LAS f32x4*)(xch + 1024 + (ai * 128 + wr * 64 + m * 16 + fr) * 4);
                const float inv = 1.f / ((t[0] + t[1]) + (t[2] + t[3]));
                const int row = u.pm * 256 + ai * 128 + wr * 64 + m * 16 + fr;
#pragma unroll
                for (int bj = 0; bj < 2; ++bj) { const f32x4 a = acc[ai][bj][m][0] * inv, b = acc[ai][bj][m][1] * inv;
                    u32x4 w; w.x = pk2(a[0], a[1]); w.y = pk2(a[2], a[3]); w.z = pk2(b[0], b[1]); w.w = pk2(b[2], b[3]);
                    *(u32x4*)(P + (size_t)row * 1024 + u.pn * 256 + bj * 128 + wc * 32 + 8 * fq) = w; }
            }
    } };
struct FVw { bf16_t* VWt;
    __device__ __forceinline__ float rowscale(int) const { return 1.f; }
    __device__ __forceinline__ void f8(int row, int col, f32x4 a, f32x4 b) const {
        const int bb = col >> 10, hk = col & 1023; u32x4 w; w.x = pk2(a[0], a[1]); w.y = pk2(a[2], a[3]); w.z = pk2(b[0], b[1]); w.w = pk2(b[2], b[3]);
        *(u32x4*)(VWt + ((size_t)bb * D + row) * 1024 + hk) = w; } };
struct FQkSplit { bf16_t* Qm; size_t kdelta;
    __device__ __forceinline__ float rowscale(int) const { return 1.f; }
    __device__ __forceinline__ void operator()(int row, int col, f32x4 v) const {
        const int h = col >> 9, j = col & 511; bf16_t* dst = Qm + (size_t)(j >> 8) * kdelta + (size_t)row * 1024 + h * 256 + (j & 255);
        u32x2 w; w.x = pk2(v[0], v[1]); w.y = pk2(v[2], v[3]); *(u32x2*)dst = w; }
    __device__ __forceinline__ void f8(int row, int col, f32x4 a, f32x4 b) const {
        const int h = col >> 9, j = col & 511; bf16_t* dst = Qm + (size_t)(j >> 8) * kdelta + (size_t)row * 1024 + h * 256 + (j & 255);
        u32x4 w; w.x = pk2(a[0], a[1]); w.y = pk2(a[2], a[3]); w.z = pk2(b[0], b[1]); w.w = pk2(b[2], b[3]); *(u32x4*)dst = w; } };
struct FMk { bf16_t* MK; float* out;
    __device__ __forceinline__ float rowscale(int) const { return 1.f; }
    __device__ __forceinline__ void operator()(int row, int col, f32x4 v) const {
        u32x2 w; w.x = pk2(v[0], v[1]); w.y = pk2(v[2], v[3]); *(u32x2*)(MK + (size_t)row * D + col) = w; __builtin_nontemporal_store(v, (f32x4*)(out + (size_t)row * D + col)); } };
struct FMvt { bf16_t* MVt; float* out;
    __device__ __forceinline__ float rowscale(int) const { return 1.f; }
    __device__ __forceinline__ void operator()(int row, int col, f32x4 v) const {
        u32x2 w; w.x = pk2(v[0], v[1]); w.y = pk2(v[2], v[3]); *(u32x2*)(MVt + ((size_t)(col >> 8) * D + row) * 256 + (col & 255)) = w;
#pragma unroll
        for (int e = 0; e < 4; ++e) out[(size_t)(col + e) * D + row] = v[e]; } };
struct FPart { float* P; int ld;
    __device__ __forceinline__ float rowscale(int) const { return 1.f; }
    __device__ __forceinline__ void operator()(int row, int col, f32x4 v) const { *(f32x4*)(P + (size_t)row * ld + col) = v; } };
struct FRi { bf16_t* R; size_t plane;
    __device__ __forceinline__ float rowscale(int) const { return 1.f; }
    __device__ __forceinline__ void operator()(int row, int col, f32x4 v) const {
        const int h = col >> 8, isI = (col >> 7) & 1, ch = h * 128 + (col & 127); u32x2 w; w.x = pk2(v[0], v[1]); w.y = pk2(v[2], v[3]); *(u32x2*)(R + (size_t)isI * plane + (size_t)row * 1024 + ch) = w; }
    __device__ __forceinline__ void f8(int row, int col, f32x4 a, f32x4 b) const {
        const int h = col >> 8, isI = (col >> 7) & 1, ch = h * 128 + (col & 127); u32x4 w; w.x = pk2(a[0], a[1]); w.y = pk2(a[2], a[3]); w.z = pk2(b[0], b[1]); w.w = pk2(b[2], b[3]);
        *(u32x4*)(R + (size_t)isI * plane + (size_t)row * 1024 + ch) = w; } };
__device__ __forceinline__ f32x2 gate_one(float rp, float ip, float ba, float bx, float sp, float xc) {
    const float r = sigmoidf_(rp + ba), i = sigmoidf_(ip + bx);
    const float la = -8.f * r * sp;
    const float a = __expf(la);
    return (f32x2){a, sqrtf(fmaxf(1.f - a * a, 0.f)) * (i * xc)};
}
template <class G>
__device__ __forceinline__ void skinny_piece(const bf16_t* A, int lda, const bf16_t* Bt, int ldb, int Kc, int ncol0, int row0, const G& g, const int w, LAS float* red) {
    const int lane = lane_id(), fr = lane & 15, fq = lane >> 4;
    const int kw = Kc >> 3, wk = (w + (int)blockIdx.x) & 7;
    f32x4 acc[8][2];
#pragma unroll
    for (int r = 0; r < 8; ++r) { acc[r][0] = (f32x4){0.f, 0.f, 0.f, 0.f}; acc[r][1] = (f32x4){0.f, 0.f, 0.f, 0.f}; }
    const bf16_t* ap = A + (size_t)fr * lda + wk * kw + 8 * fq;
    const bf16_t* bp = Bt + (size_t)(ncol0 + fr) * ldb + wk * kw + 8 * fq;
#pragma unroll 4
    for (int k = 0; k < kw; k += 32) {
        const bf16x8 b0 = ld8(bp + k), b1 = ld8(bp + (size_t)16 * ldb + k);
#pragma unroll
        for (int r = 0; r < 8; ++r) { const bf16x8 a = ld8(ap + (size_t)(16 * r) * lda + k); acc[r][0] = MFMA16(b0, a, acc[r][0]); acc[r][1] = MFMA16(b1, a, acc[r][1]); }
    }
    __syncthreads();
#pragma unroll
    for (int r = 0; r < 8; ++r)
#pragma unroll
        for (int t = 0; t < 2; ++t) *(LAS f32x4*)(red + ((w * 16 + r * 2 + t) * 64 + lane) * 4) = acc[r][t];
    __syncthreads();
#pragma unroll
    for (int t = 0; t < 2; ++t) {
        f32x4 s = (f32x4){0.f, 0.f, 0.f, 0.f};
#pragma unroll
        for (int ww = 0; ww < 8; ++ww) s = s + *(const LAS f32x4*)(red + ((ww * 16 + w * 2 + t) * 64 + lane) * 4);
        g(row0 + 16 * w + fr, ncol0 + 16 * t + 4 * fq, s * g.rowscale(row0 + 16 * w + fr));
    }
}
template <class G>
__device__ __forceinline__ void skinny_gemm(const bf16_t* A, int lda, const bf16_t* Bt, int ldb, int K, int N, int ksplit, int cu0, int ncu, int row0, const G& g, int part_rows, const int w, LAS float* red) {
    const int me = (int)blockIdx.x - cu0; if (me < 0 || me >= ncu) return;
    const int nsl = N / 32, np = nsl * ksplit, Kc = K / ksplit;
    for (int p = me; p < np; p += ncu) {
        const int sl = p % nsl, ks = p / nsl;
        skinny_piece(A + (size_t)ks * Kc, lda, Bt + (size_t)ks * Kc, ldb, Kc, 32 * sl, row0 + ks * part_rows, g, w, red);
    }
}
#define XB_TMO      128
#define XB_XCNT(j)  (256  + 64 * (j))
#define XB_XSUB(j)  (1280 + 64 * (j))
#define XB_XGEN(j)  (2304 + 64 * (j))
#define XB_TOP      3328
#define XB_TOPGEN   3392
#define XCD_BAR_WORDS 3456
#define XB_SPIN_CAP (1u << 18)
__device__ __forceinline__ unsigned xb_ld(unsigned* p)              { return __hip_atomic_load(p, __ATOMIC_RELAXED, __HIP_MEMORY_SCOPE_AGENT); }
__device__ __forceinline__ unsigned xb_add(unsigned* p, unsigned v) { return __hip_atomic_fetch_add(p, v, __ATOMIC_RELAXED, __HIP_MEMORY_SCOPE_AGENT); }
__device__ __forceinline__ unsigned xb_xcc_id() { return (unsigned)__builtin_amdgcn_s_getreg((3 << 11) | 20) & 0xFu; }
#define XB_SPIN(cond, bar) do { unsigned _sp = 0; while (cond) { __builtin_amdgcn_s_sleep(1); \
    if ((++_sp & 255u) == 0u) { if (xb_ld(&(bar)[XB_TMO])) break; if (_sp > XB_SPIN_CAP) { atomicAdd(&(bar)[XB_TMO], 1u); break; } } } } while (0)
struct XcdBarrier { unsigned* bar; unsigned x; volatile LAS unsigned* st; };
__device__ __forceinline__ void xcd_barrier_complete(unsigned* bar, unsigned x, unsigned& nloc, unsigned& nx) {
    const unsigned G = gridDim.x * gridDim.y * gridDim.z;
    unsigned sum, cnt, mine, sp = 0u;
    for (;;) {
        sum = 0u; cnt = 0u; mine = 0u;
#pragma unroll
        for (unsigned j = 0; j < 16; ++j) { const unsigned c = xb_ld(&bar[XB_XCNT(j)]); sum += c; cnt += (c > 0u) ? 1u : 0u; mine = (j == x) ? c : mine; }
        if (sum == G) break;
        __builtin_amdgcn_s_sleep(1);
        if ((++sp & 255u) == 0u) { if (xb_ld(&bar[XB_TMO])) break; if (sp > XB_SPIN_CAP) { atomicAdd(&bar[XB_TMO], 1u); break; } }
    }
    nloc = mine > 0u ? mine : 1u; nx = cnt > 0u ? cnt : 1u;
}
__device__ __forceinline__ void xcd_barrier(const XcdBarrier& b, const int wave) {
    asm volatile("s_waitcnt vmcnt(0)" ::: "memory");
    __syncthreads();
    if (wave == 0 && lane_id() == 0) {
        unsigned* bar = b.bar;
        __builtin_amdgcn_s_waitcnt(0);
        unsigned nloc = b.st[0], nx = b.st[1];
        if (nloc == 0u) { xcd_barrier_complete(bar, b.x, nloc, nx); b.st[0] = nloc; b.st[1] = nx; }
        const unsigned old = xb_add(&bar[XB_XSUB(b.x)], 1u);
        const unsigned gen = old / nloc;
        if (old + 1u == (gen + 1u) * nloc) {
            __builtin_amdgcn_fence(__ATOMIC_RELEASE, "agent");
            asm volatile("s_waitcnt vmcnt(0)" ::: "memory");
            const unsigned og = xb_add(&bar[XB_TOP], 1u);
            const unsigned tg = og / nx;
            if (og + 1u == (tg + 1u) * nx) xb_add(&bar[XB_TOPGEN], 1u);
            else XB_SPIN(xb_ld(&bar[XB_TOPGEN]) == tg, bar);
            __builtin_amdgcn_fence(__ATOMIC_ACQUIRE, "agent");
            xb_add(&bar[XB_XGEN(b.x)], 1u);
            asm volatile("s_waitcnt vmcnt(0)" ::: "memory");
        } else {
            XB_SPIN(xb_ld(&bar[XB_XGEN(b.x)]) == gen, bar);
            __builtin_amdgcn_fence(__ATOMIC_ACQUIRE, "agent");
            asm volatile("s_waitcnt vmcnt(0)" ::: "memory");
        }
    }
    __syncthreads();
}

struct Args { const float* in[39]; float* out; unsigned char* ws; int ph_lo, ph_hi; };
enum { I_XP = 0, I_XS, I_MEM, I_SRH, I_SRC, I_SMC_, I_SMN, I_SMM, I_SMCV, I_CK, I_CV, I_GMIX, I_WIN, I_CRW, I_CRB, I_WA, I_BA, I_WX, I_BX, I_LAM, I_GRNN,
       I_CMW, I_CMB, I_WQ, I_WK, I_BI, I_BF, I_GML, I_WOUT, I_GX, I_GMEM, I_WCQ, I_WMK, I_WMV, I_WCO, I_GFFN, I_WUP, I_WDN, I_GFIN };

__device__ __forceinline__ void transpose_item(const float* W, int ldw, bf16_t* WT, int ldt, LAS float* scr, int kb, int nb, int lane) {
    const int k0 = 64 * kb, n0 = 32 * nb;
    f32x4 ld[8];
#pragma unroll
    for (int i = 0; i < 8; ++i) ld[i] = __builtin_nontemporal_load((const f32x4*)(W + (size_t)(k0 + 8 * i + (lane >> 3)) * ldw + n0 + 4 * (lane & 7)));
#pragma unroll
    for (int i = 0; i < 8; ++i) { LAS float* d = scr + (8 * i + (lane >> 3)) * 33 + 4 * (lane & 7); d[0] = ld[i][0]; d[1] = ld[i][1]; d[2] = ld[i][2]; d[3] = ld[i][3]; }
    asm volatile("s_waitcnt lgkmcnt(0)" ::: "memory");
    const int c = lane & 7;
#pragma unroll
    for (int j = 0; j < 4; ++j) { const int n = (lane >> 3) + 8 * j; const LAS float* s = scr + (8 * c) * 33 + n;
        u32x4 o; o.x = pk2(s[0 * 33], s[1 * 33]); o.y = pk2(s[2 * 33], s[3 * 33]); o.z = pk2(s[4 * 33], s[5 * 33]); o.w = pk2(s[6 * 33], s[7 * 33]);
        *(u32x4*)(WT + (size_t)(n0 + n) * ldt + k0 + 8 * c) = o; }
    asm volatile("s_waitcnt lgkmcnt(0)" ::: "memory");
}
__device__ __forceinline__ void convert_matrix(const float* W, int ldw, int K, int N, bf16_t* WT, int ldt, LAS float* scr, int gw_, int ngw_, int lane) {
    const int nb = N / 32, items = (K / 64) * nb;
    for (int it = gw_; it < items; it += ngw_) transpose_item(W, ldw, WT, ldt, scr, it / nb, it % nb, lane);
}
__device__ __forceinline__ void load_gain(const float* g, int lane, f32x4 (&gg)[8]) {
#pragma unroll
    for (int j = 0; j < 8; ++j) gg[j] = *(const f32x4*)(g + 256 * j + 4 * lane);
}
__device__ __forceinline__ void norm_row(const float* xrow, const f32x4 (&gg)[8], bf16_t* orow, int lane) {
    f32x4 v[8]; float ss = 0.f;
#pragma unroll
    for (int j = 0; j < 8; ++j) { v[j] = __builtin_nontemporal_load((const f32x4*)(xrow + 256 * j + 4 * lane)); ss += (v[j][0] * v[j][0] + v[j][1] * v[j][1]) + (v[j][2] * v[j][2] + v[j][3] * v[j][3]); }
    const float rstd = rsqrtf(wave_sum(ss) * (1.f / D) + EPS);
#pragma unroll
    for (int j = 0; j < 8; ++j) { const f32x4 a = v[j] * rstd * gg[j]; u32x2 w; w.x = pk2(a[0], a[1]); w.y = pk2(a[2], a[3]); *(u32x2*)(orow + 256 * j + 4 * lane) = w; }
}

#define wsWinT ((bf16_t*)(ws + WS_WIN2))
#define wsWoutT ((bf16_t*)(ws + WS_WOUT))
#define wsWcqT ((bf16_t*)(ws + WS_WCQ))
#define wsWmkT ((bf16_t*)(ws + WS_WMK))
#define wsWmvT ((bf16_t*)(ws + WS_WMV))
#define wsWcoT ((bf16_t*)(ws + WS_WCO))
#define wsWupT ((bf16_t*)(ws + WS_WUP))
#define wsWdnT ((bf16_t*)(ws + WS_WDN))
#define wsWgT ((bf16_t*)(ws + WS_WG))
#define wsWqkT ((bf16_t*)(ws + WS_WQK))
#define wsXN ((bf16_t*)(ws + WS_XN))
#define wsMN ((bf16_t*)(ws + WS_MN))
#define wsZ ((bf16_t*)(ws + WS_Z))
#define wsGATES ((float*)(ws + WS_GATES))
#define wsXC ((bf16_t*)(ws + WS_XC))
#define wsUC ((bf16_t*)(ws + WS_UC))
#define wsAU ((bf16_t*)(ws + WS_AU))
#define wsQm ((bf16_t*)(ws + WS_QM))
#define wsKm ((bf16_t*)(ws + WS_KM))
#define wsY ((bf16_t*)(ws + WS_Y))
#define wsX1 ((bf16_t*)(ws + WS_X1))
#define wsX2 ((bf16_t*)(ws + WS_X2))
#define wsQC ((bf16_t*)(ws + WS_QC))
#define wsOC ((bf16_t*)(ws + WS_OC))
#define wsMK ((bf16_t*)(ws + WS_MK))
#define wsMVt ((bf16_t*)(ws + WS_MVT))
#define wsVW ((bf16_t*)(ws + WS_Y))
#define wsU ((bf16_t*)(ws + WS_U))
#define wsCLOC ((bf16_t*)(ws + WS_CLOC))
#define wsCIN ((bf16_t*)(ws + WS_CIN))
#define wsNLOC ((float*)(ws + WS_NLOC))
#define wsNIN ((float*)(ws + WS_NIN))
#define wsMSTAT ((float*)(ws + WS_MSTAT))
#define wsMINB (wsMSTAT + 1024)
#define wsSUM ((float*)(ws + WS_SUM))
#define wsPART ((float*)(ws + WS_PART))
#define wsSPL (wsMSTAT + 4096)
#define wsSS (wsMSTAT + 8192)
#define wsPB ((bf16_t*)(ws + WS_U))
__global__ void __launch_bounds__(512, 2) mega_fwd(Args args) {
    extern __shared__ __attribute__((aligned(16))) unsigned char lds_raw[];
    LAS unsigned char* lds = (LAS unsigned char*)lds_raw;
    LAS float* misc = (LAS float*)(lds + MISC_OFF);
    const int wave = __builtin_amdgcn_readfirstlane((int)threadIdx.x >> 6);
    const int G = gridDim.x, bid = blockIdx.x;
    const int NGW = G * 8, NGT = G * 512;
#define PH_IDS const int lane = lane_id(); const int tid = wave * 64 + lane; const int gw = bid * 8 + wave; const int gt = bid * 512 + tid; (void)gw; (void)gt; (void)lane; (void)tid;
    unsigned char* ws = args.ws;
    float* out = args.out;
    volatile LAS unsigned* bst = (volatile LAS unsigned*)(lds + LDS_BYTES - 16);
    if (wave == 0 && lane_id() == 0) { bst[0] = 0u; bst[1] = 0u; }
    __syncthreads();
    XcdBarrier xbar; xbar.bar = (unsigned*)(ws + WS_CTL); xbar.x = xb_xcc_id(); xbar.st = bst;
    if (wave == 0 && lane_id() == 0) (void)xb_add(&xbar.bar[XB_XCNT(xbar.x)], 1u);
    const int lo = args.ph_lo, hi = args.ph_hi;
#ifndef PH_MASK
#define PH_MASK 0xFFFF
#endif
#define IN(k) (((PH_MASK >> (k)) & 1) && lo <= (k) && (k) < hi)
#ifndef DUP_MASK
#define DUP_MASK 0
#endif
#define REP(k) for (int rep_ = 0; rep_ <= ((DUP_MASK >> (k)) & 1); ++rep_)
#ifndef DUP_BAR
#define DUP_BAR 0
#endif
#define SEAM(k) do { if (IN(k)) { xcd_barrier(xbar, wave); if (DUP_BAR) { xcd_barrier(xbar, wave); xcd_barrier(xbar, wave); } } } while (0)

    REP(0) if (IN(0)) { PH_IDS
        LAS float* scr = (LAS float*)(lds + wave * 16384);
        constexpr int I_A = 32 * 160, I_S = 32 * 64, NIT = I_A + 3 * I_S;
        for (int it = gw; it < NIT; it += NGW) {
            int r = it;
            if (r < I_A) { transpose_item(args.in[I_WIN], DIN, wsWinT, D, scr, r / 160, r % 160, lane); continue; } r -= I_A;
            if (r < I_S) { transpose_item(args.in[I_WOUT], D, wsWoutT, D, scr, r / 64, r % 64, lane); continue; } r -= I_S;
            if (r < I_S) { transpose_item(args.in[I_WMK], D, wsWmkT, D, scr, r / 64, r % 64, lane); continue; } r -= I_S;
            transpose_item(args.in[I_WMV], D, wsWmvT, D, scr, r / 64, r % 64, lane);
        }
        for (int idx = gt; idx < 8 * 256 * 256; idx += NGT) {
            const int h = idx >> 16, j = (idx >> 8) & 255, k = idx & 255, kk = k - (h & 1) * 128;
            float v = 0.f;
            if (kk >= 0 && kk < 128) v = (j < 128) ? args.in[I_WA][((size_t)h * 128 + kk) * 128 + j] : args.in[I_WX][((size_t)h * 128 + kk) * 128 + (j - 128)];
            wsWgT[idx] = (bf16_t)f2bf(v);
        }
        for (int idx = gt; idx < 4 * 512 * 256; idx += NGT) {
            const int h = idx >> 17, j = (idx >> 8) & 511, k = idx & 255;
            const float v = (j < 256) ? args.in[I_WQ][((size_t)h * 256 + k) * 256 + j] : args.in[I_WK][((size_t)h * 256 + k) * 256 + (j - 256)] * 0.0625f;
            wsWqkT[idx] = (bf16_t)f2bf(v);
        }
        for (int idx = gt; idx < 2 * MT; idx += NGT) wsSS[idx] = 0.f;
        for (int idx = gt; idx < 1024; idx += NGT) { const float l = args.in[I_LAM][idx]; wsSPL[idx] = fmaxf(-l, 0.f) + log1pf(__expf(-fabsf(l))); }
        for (int idx = gt; idx < 8 * 2048; idx += NGT) { const int c = idx >> 11, k = idx & 2047; wsWinT[(size_t)(NZ + c) * D + k] = (bf16_t)f2bf(args.in[I_WIN][(size_t)k * DIN + NZ + c]); }
        { f32x4 gg[8]; load_gain(args.in[I_GMIX], lane, gg);
          for (int m = gw; m < MT; m += NGW) { const float* xrow = m < MP ? args.in[I_XP] + (size_t)m * D : args.in[I_XS] + (size_t)(m - MP) * D; norm_row(xrow, gg, wsXN + (size_t)m * D, lane); } }
        { f32x4 gg[8]; load_gain(args.in[I_GMEM], lane, gg);
          for (int m = gw; m < MMEM; m += NGW) norm_row(args.in[I_MEM] + (size_t)m * D, gg, wsMN + (size_t)m * D, lane); }
        __syncthreads();
    }
    SEAM(0);

    REP(1) if (IN(1)) { PH_IDS
        { const pg8::Gemm g = pg8::mk_gemm(wsXN, wsWinT, D * 2, D * 2, D, 0); pg8::StaticOrder S; S.init(33, 21, G, bid);
          pg8::EpiF8<FZ> E{{wsZ, wsGATES}}; pg8::gemm_phase<pg8::EpiF8<FZ>, true, true>(lds, g, S, E, wave); }
        { const pg8::Gemm g = pg8::mk_gemm(wsMN, wsWmkT, D * 2, D * 2, D, 0); pg8::StaticOrder S; S.init(4, 8, G, G - 1 - bid);
          pg8::EpiF<FMk> E{{wsMK, out + O_PK}}; pg8::gemm_phase<pg8::EpiF<FMk>, true, true>(lds, g, S, E, wave); }
        { const pg8::Gemm g = pg8::mk_gemm(wsMN, wsWmvT, D * 2, D * 2, D, 0); pg8::StaticOrder S; S.init(4, 8, G, G - 33 - bid);
          pg8::EpiF<FMk> E{{wsMVt, out + O_PV}}; pg8::gemm_phase<pg8::EpiF<FMk>, true, true>(lds, g, S, E, wave); }
    }
    SEAM(1);

    REP(2) if (IN(2)) { PH_IDS
        const int gi = gt & 255, which = gi >> 7, c0 = (gi & 127) * 8, zc = (which ? OFF_MU : OFF_RX) + c0;
        const float* cw = args.in[which ? I_CMW : I_CRW]; const float* cb = args.in[which ? I_CMB : I_CRB];
        float wt[4][8], wb[8];
#pragma unroll
        for (int e = 0; e < 8; ++e) { wb[e] = cb[c0 + e];
#pragma unroll
            for (int j = 0; j < 4; ++j) wt[j][e] = cw[j * 1024 + c0 + e]; }
        for (int m = gt >> 8; m < MT; m += NGT >> 8) {
            float x[4][8];
            if (m < MP) {
                const int t = m & (TT - 1);
#pragma unroll
                for (int j = 0; j < 4; ++j) {
                    if (t - 3 + j >= 0) { const u32x4 w = *(const u32x4*)(wsZ + (size_t)(m - 3 + j) * NZ + zc);
                        x[j][0] = bflo(w.x); x[j][1] = bfhi(w.x); x[j][2] = bflo(w.y); x[j][3] = bfhi(w.y); x[j][4] = bflo(w.z); x[j][5] = bfhi(w.z); x[j][6] = bflo(w.w); x[j][7] = bfhi(w.w); }
                    else {
#pragma unroll
                        for (int e = 0; e < 8; ++e) x[j][e] = 0.f; }
                }
                if (t >= TT - 3) { float* o = out + (which ? O_PMC : O_PRC) + ((size_t)(m >> 11) * 3 + (t - (TT - 3))) * 1024 + c0;
                    *(f32x4*)o = (f32x4){x[3][0], x[3][1], x[3][2], x[3][3]}; *(f32x4*)(o + 4) = (f32x4){x[3][4], x[3][5], x[3][6], x[3][7]}; }
            } else {
                const int sb = m - MP; const float* st = args.in[which ? I_SMCV : I_SRC] + (size_t)sb * 3 * 1024 + c0;
#pragma unroll
                for (int j = 0; j < 3; ++j) { const f32x4 a = *(const f32x4*)(st + j * 1024), b = *(const f32x4*)(st + j * 1024 + 4);
                    x[j][0] = a[0]; x[j][1] = a[1]; x[j][2] = a[2]; x[j][3] = a[3]; x[j][4] = b[0]; x[j][5] = b[1]; x[j][6] = b[2]; x[j][7] = b[3]; }
                const u32x4 w = *(const u32x4*)(wsZ + (size_t)m * NZ + zc);
                x[3][0] = bflo(w.x); x[3][1] = bfhi(w.x); x[3][2] = bflo(w.y); x[3][3] = bfhi(w.y); x[3][4] = bflo(w.z); x[3][5] = bfhi(w.z); x[3][6] = bflo(w.w); x[3][7] = bfhi(w.w);
                float* o = out + (which ? O_SMC : O_SRC) + (size_t)sb * 3 * 1024 + c0;
#pragma unroll
                for (int j = 0; j < 3; ++j) { *(f32x4*)(o + j * 1024) = (f32x4){x[j + 1][0], x[j + 1][1], x[j + 1][2], x[j + 1][3]}; *(f32x4*)(o + j * 1024 + 4) = (f32x4){x[j + 1][4], x[j + 1][5], x[j + 1][6], x[j + 1][7]}; }
            }
            float y[8];
#pragma unroll
            for (int e = 0; e < 8; ++e) y[e] = wb[e];
#pragma unroll
            for (int j = 0; j < 4; ++j)
#pragma unroll
                for (int e = 0; e < 8; ++e) y[e] += wt[j][e] * x[j][e];
            if (which) {
#pragma unroll
                for (int e = 0; e < 8; ++e) y[e] = y[e] * sigmoidf_(y[e]);
            }
            u32x4 w; w.x = pk2(y[0], y[1]); w.y = pk2(y[2], y[3]); w.z = pk2(y[4], y[5]); w.w = pk2(y[6], y[7]);
            *(u32x4*)((which ? wsUC : wsXC) + (size_t)m * 1024 + c0) = w;
        }
    }
    SEAM(2);

    REP(3) if (IN(3)) { PH_IDS
        { const pg8::Gemm g = pg8::mk_gemm(wsXC, wsWgT, 2048, 512, 256, 512); pg8::StaticOrder S; S.init(32, 8, G, bid);
          pg8::EpiF8<FRi> E{{wsAU, (size_t)MT * 1024}}; pg8::gemm_phase<pg8::EpiF8<FRi>, true, true>(lds, g, S, E, wave); }
        { const pg8::Gemm g = pg8::mk_gemm(wsUC, wsWqkT, 2048, 512, 256, 512); pg8::StaticOrder S; S.init(32, 8, G, bid);
          pg8::EpiF8<FQkSplit> E{{wsQm, (WS_KM - WS_QM) / 2}}; pg8::gemm_phase<pg8::EpiF8<FQkSplit>, true, true>(lds, g, S, E, wave); }
        if (bid < 64) { const int h = bid >> 3;
            skinny_piece(wsXC + (size_t)MP * 1024 + 256 * (h >> 1), 1024, wsWgT, 256, 256, 32 * bid, MP, FRi{wsAU, (size_t)MT * 1024}, wave, (LAS float*)lds); }
        else if (bid < 128) { const int p = bid - 64; const int hh = p >> 4;
            skinny_piece(wsUC + (size_t)MP * 1024 + 256 * hh, 1024, wsWqkT, 256, 256, 32 * p, MP, FQkSplit{wsQm, (WS_KM - WS_QM) / 2}, wave, (LAS float*)lds); }
    }
    SEAM(3);

    REP(4) if (IN(4)) { PH_IDS
        for (int u = bid; u < 256; u += G) {
            const int m0 = (u >> 6) * TT + (u & 63) * 32;
            float A0 = 1.f, A1 = 1.f, h0 = 0.f, h1 = 0.f;
            const f32x2 ba = *(const f32x2*)(args.in[I_BA] + 2 * tid), bx = *(const f32x2*)(args.in[I_BX] + 2 * tid), sp = *(const f32x2*)(wsSPL + 2 * tid);
#pragma unroll 8
            for (int i = 0; i < 32; ++i) { const size_t o = (size_t)(m0 + i) * 1024 + 2 * tid;
                const unsigned rw_ = *(const unsigned*)(wsAU + o), iw_ = *(const unsigned*)(wsAU + (size_t)MT * 1024 + o); const f32x2 rp = (f32x2){bflo(rw_), bfhi(rw_)}, ip = (f32x2){bflo(iw_), bfhi(iw_)}; const unsigned xw = *(const unsigned*)(wsXC + o);
                const f32x2 g0 = gate_one(rp[0], ip[0], ba[0], bx[0], sp[0], bflo(xw)), g1 = gate_one(rp[1], ip[1], ba[1], bx[1], sp[1], bfhi(xw));
                h0 = g0[0] * h0 + g0[1]; A0 *= g0[0]; h1 = g1[0] * h1 + g1[1]; A1 *= g1[0]; }
            *(f32x4*)(wsSUM + ((size_t)u * 1024 + 2 * tid) * 2) = (f32x4){A0, h0, A1, h1};
        }
        for (int u = bid; u < 256; u += G) {
            const int bh = u >> 4, c = u & 15, b = bh >> 2, h = bh & 3, m0 = b * TT + c * 128;
            LAS float* ic = misc; LAS float* bb = misc + 128; LAS float* wv = misc + 256; LAS float* sc = misc + 384;
            __syncthreads();
            if (tid < 128) { ic[tid] = wsGATES[(size_t)(m0 + tid) * 8 + h] + args.in[I_BI][h]; bb[tid] = logsigmoid_(wsGATES[(size_t)(m0 + tid) * 8 + 4 + h] + args.in[I_BF][h]); }
            __syncthreads();
            if (wave == 0) {
                const float x0 = bb[2 * lane], x1 = bb[2 * lane + 1], loc = x0 + x1; float inc = loc;
#pragma unroll
                for (int o = 1; o < 64; o <<= 1) { const float t = __shfl_up(inc, o); if (lane >= o) inc += t; }
                const float b0 = inc - x1, b1 = inc, a = __shfl(inc, 63);
                const float mx = wave_max(fmaxf(ic[2 * lane] + a - b0, ic[2 * lane + 1] + a - b1));
                bb[2 * lane] = b0; bb[2 * lane + 1] = b1;
                if (lane == 0) { sc[0] = mx; sc[1] = a; wsMSTAT[u * 2] = mx; wsMSTAT[u * 2 + 1] = a; }
            }
            __syncthreads();
            if (tid < 128) wv[tid] = __expf(ic[tid] + sc[1] - bb[tid] - sc[0]);
            __syncthreads();
            LAS unsigned char* VTl = lds; LAS unsigned char* KTl = lds + 67584;
            for (int idx = tid; idx < 128 * 32; idx += 512) {
                const int s = idx >> 5, ch = idx & 31; const float w = wv[s];
                const u32x4 v = *(const u32x4*)(wsZ + (size_t)(m0 + s) * NZ + OFF_MV + h * 256 + ch * 8);
                u32x4 o; o.x = pk2(bflo(v.x) * w, bfhi(v.x) * w); o.y = pk2(bflo(v.y) * w, bfhi(v.y) * w); o.z = pk2(bflo(v.z) * w, bfhi(v.z) * w); o.w = pk2(bflo(v.w) * w, bfhi(v.w) * w);
                *(LAS u32x4*)(VTl + s * 528 + ch * 16) = o;
                *(LAS u32x4*)(KTl + s * 528 + ch * 16) = *(const u32x4*)(wsKm + (size_t)(m0 + s) * 1024 + h * 256 + ch * 8);
            }
            __syncthreads();
            {
                const int g4 = lane >> 4, q = (lane & 15) >> 2, p = lane & 3;
                f32x4 acc[2][16];
#pragma unroll
                for (int a = 0; a < 2; ++a)
#pragma unroll
                    for (int k = 0; k < 16; ++k) acc[a][k] = (f32x4){0.f, 0.f, 0.f, 0.f};
                for (int ks = 0; ks < 4; ++ks) {
                    const int rb = (32 * ks + 8 * g4 + q) * 528 + 8 * p;
                    bf16x8 yv[2];
#pragma unroll
                    for (int a = 0; a < 2; ++a) yv[a] = cat8(tr_read(VTl + rb + (32 * wave + 16 * a) * 2), tr_read(VTl + rb + 4 * 528 + (32 * wave + 16 * a) * 2));
#pragma unroll
                    for (int kt = 0; kt < 16; ++kt) {
                        const bf16x8 xk = cat8(tr_read(KTl + rb + 32 * kt), tr_read(KTl + rb + 4 * 528 + 32 * kt));
                        acc[0][kt] = MFMA16(xk, yv[0], acc[0][kt]); acc[1][kt] = MFMA16(xk, yv[1], acc[1][kt]);
                    }
                }
#pragma unroll
                for (int a = 0; a < 2; ++a)
#pragma unroll
                    for (int kt = 0; kt < 16; ++kt) { u32x2 w; w.x = pk2(acc[a][kt][0], acc[a][kt][1]); w.y = pk2(acc[a][kt][2], acc[a][kt][3]);
                        *(u32x2*)(wsCLOC + (size_t)u * 65536 + (size_t)(32 * wave + 16 * a + (lane & 15)) * 256 + 16 * kt + 4 * g4) = w; }
            }
            if (tid < 256) { float s = 0.f; for (int i = 0; i < 128; ++i) s += wv[i] * bf2f(*(const LAS bf16_t*)(KTl + i * 528 + tid * 2)); wsNLOC[(size_t)u * 256 + tid] = s; }
            __syncthreads();
        }
    }
    SEAM(4);

    REP(5) if (IN(5)) { PH_IDS
        for (int st_ = 0; st_ < 3; ++st_) { const int which = (bid & 1) ? (st_ + 2) % 3 : st_;
        __syncthreads();
        if (which == 0) for (int u = bid; u < 288; u += G) {
            LAS float* tile = (LAS float*)lds;
            __syncthreads();
            if (u < 256) {
                const int b = u >> 6, ch = u & 63, m0 = b * TT + ch * 32;
                float h0 = 0.f, h1 = 0.f;
                const f32x2 ba = *(const f32x2*)(args.in[I_BA] + 2 * tid), bx = *(const f32x2*)(args.in[I_BX] + 2 * tid), sp = *(const f32x2*)(wsSPL + 2 * tid);
#pragma unroll 16
                for (int cc = 0; cc < ch; ++cc) { const f32x4 q = *(const f32x4*)(wsSUM + ((size_t)(b * 64 + cc) * 1024 + 2 * tid) * 2); h0 = q[0] * h0 + q[1]; h1 = q[2] * h1 + q[3]; }
#pragma unroll 8
                for (int i = 0; i < 32; ++i) {
                    const size_t o = (size_t)(m0 + i) * 1024 + 2 * tid;
                    const unsigned rw_ = *(const unsigned*)(wsAU + o), iw_ = *(const unsigned*)(wsAU + (size_t)MT * 1024 + o); const f32x2 rp = (f32x2){bflo(rw_), bfhi(rw_)}, ip = (f32x2){bflo(iw_), bfhi(iw_)}; const unsigned xw = *(const unsigned*)(wsXC + o);
                    const f32x2 g0 = gate_one(rp[0], ip[0], ba[0], bx[0], sp[0], bflo(xw)), g1 = gate_one(rp[1], ip[1], ba[1], bx[1], sp[1], bfhi(xw));
                    h0 = g0[0] * h0 + g0[1]; h1 = g1[0] * h1 + g1[1];
                    const unsigned gr = *(const unsigned*)(wsZ + (size_t)(m0 + i) * NZ + OFF_RG + 2 * tid);
                    *(LAS f32x2*)(tile + i * 1024 + 2 * tid) = (f32x2){h0 * gelu_tanh(bflo(gr)), h1 * gelu_tanh(bfhi(gr))};
                }
                if (ch == 63) *(f32x2*)(out + O_PH + (size_t)b * 1024 + 2 * tid) = (f32x2){h0, h1};
            } else {
                const int sb0 = (u - 256) * 4;
                const f32x2 ba = *(const f32x2*)(args.in[I_BA] + 2 * tid), bx = *(const f32x2*)(args.in[I_BX] + 2 * tid), sp = *(const f32x2*)(wsSPL + 2 * tid);
#pragma unroll
                for (int i = 0; i < 4; ++i) {
                    const int sb = sb0 + i, m = MP + sb;
                    const size_t o = (size_t)m * 1024 + 2 * tid;
                    const unsigned rw_ = *(const unsigned*)(wsAU + o), iw_ = *(const unsigned*)(wsAU + (size_t)MT * 1024 + o); const f32x2 rp = (f32x2){bflo(rw_), bfhi(rw_)}, ip = (f32x2){bflo(iw_), bfhi(iw_)}; const unsigned xw = *(const unsigned*)(wsXC + o);
                    const f32x2 g0 = gate_one(rp[0], ip[0], ba[0], bx[0], sp[0], bflo(xw)), g1 = gate_one(rp[1], ip[1], ba[1], bx[1], sp[1], bfhi(xw));
                    const f32x2 hp = *(const f32x2*)(args.in[I_SRH] + (size_t)sb * 1024 + 2 * tid);
                    const float h0 = g0[0] * hp[0] + g0[1], h1 = g1[0] * hp[1] + g1[1];
                    *(f32x2*)(out + O_SH + (size_t)sb * 1024 + 2 * tid) = (f32x2){h0, h1};
                    const unsigned gr = *(const unsigned*)(wsZ + (size_t)m * NZ + OFF_RG + 2 * tid);
                    *(LAS f32x2*)(tile + i * 1024 + 2 * tid) = (f32x2){h0 * gelu_tanh(bflo(gr)), h1 * gelu_tanh(bfhi(gr))};
                }
            }
            __syncthreads();
            const int mrow0 = (u < 256) ? ((u >> 6) * TT + (u & 63) * 32) : (MP + (u - 256) * 4);
            const int nrows = (u < 256) ? 32 : 4;
#pragma unroll
            for (int r = 0; r < 4; ++r) {
                const int i = wave * 4 + r; if (i >= nrows) continue; f32x4 v[4]; float ss = 0.f;
#pragma unroll
                for (int j = 0; j < 4; ++j) { v[j] = *(const LAS f32x4*)(tile + i * 1024 + 256 * j + 4 * lane); ss += (v[j][0] * v[j][0] + v[j][1] * v[j][1]) + (v[j][2] * v[j][2] + v[j][3] * v[j][3]); }
                const float rstd = rsqrtf(wave_sum(ss) * (1.f / 1024.f) + EPS);
#pragma unroll
                for (int j = 0; j < 4; ++j) { const f32x4 gg = *(const f32x4*)(args.in[I_GRNN] + 256 * j + 4 * lane); const f32x4 o = v[j] * rstd * gg;
                    u32x2 w; w.x = pk2(o[0], o[1]); w.y = pk2(o[2], o[3]); *(u32x2*)(wsY + (size_t)(mrow0 + i) * D + 256 * j + 4 * lane) = w; }
            }
        }
        if (which == 1) for (int u = bid; u < 256; u += G) {
            const int bh = u >> 4, sl = u & 15, v = 16 * sl + (tid >> 5), k0 = (tid & 31) * 8;
            float cs[8];
#pragma unroll
            for (int e = 0; e < 8; ++e) cs[e] = 0.f;
            float m = 0.f, ns = 0.f;
#pragma unroll
            for (int c = 0; c < 16; ++c) {
                const int cu = bh * 16 + c; const float mloc = wsMSTAT[cu * 2], bL = wsMSTAT[cu * 2 + 1];
                const float mn = fmaxf(bL + m, mloc), al = __expf(bL + m - mn), be = __expf(mloc - mn);
                u32x4 w; w.x = pk2(cs[0], cs[1]); w.y = pk2(cs[2], cs[3]); w.z = pk2(cs[4], cs[5]); w.w = pk2(cs[6], cs[7]);
                *(u32x4*)(wsCIN + (size_t)cu * 65536 + (size_t)v * 256 + k0) = w;
                const u32x4 l = *(const u32x4*)(wsCLOC + (size_t)cu * 65536 + (size_t)v * 256 + k0);
                cs[0] = al * cs[0] + be * bflo(l.x); cs[1] = al * cs[1] + be * bfhi(l.x); cs[2] = al * cs[2] + be * bflo(l.y); cs[3] = al * cs[3] + be * bfhi(l.y);
                cs[4] = al * cs[4] + be * bflo(l.z); cs[5] = al * cs[5] + be * bfhi(l.z); cs[6] = al * cs[6] + be * bflo(l.w); cs[7] = al * cs[7] + be * bfhi(l.w);
                if (sl == 0 && tid < 256) { wsNIN[(size_t)cu * 256 + tid] = ns; ns = al * ns + be * wsNLOC[(size_t)cu * 256 + tid]; }
                if (sl == 0 && tid == 0) wsMINB[cu] = m;
                m = mn;
            }
            float* oc = out + O_PC + (size_t)bh * 65536 + (size_t)v * 256 + k0;
            *(f32x4*)oc = (f32x4){cs[0], cs[1], cs[2], cs[3]}; *(f32x4*)(oc + 4) = (f32x4){cs[4], cs[5], cs[6], cs[7]};
            if (sl == 0 && tid < 256) out[O_PN + (size_t)bh * 256 + tid] = ns;
            if (sl == 0 && tid == 0) out[O_PM + bh] = m;
        }
        if (which == 2) for (int u = bid; u < 512; u += G) {
            const int sb = u >> 2, h = u & 3, m = MP + sb;
            LAS float* red = misc;
            LAS float* hv = misc + 16;
            __syncthreads();
            const float ig = wsGATES[(size_t)m * 8 + h] + args.in[I_BI][h], lf = logsigmoid_(wsGATES[(size_t)m * 8 + 4 + h] + args.in[I_BF][h]);
            const float mp = args.in[I_SMM][sb * 4 + h];
            const float inter = lf + mp, mt = fmaxf(inter, ig), wi = __expf(inter - mt), sd = __expf(ig - mt);
            const u32x2 qw = *(const u32x2*)(wsQm + (size_t)m * 1024 + h * 256 + 4 * lane), kw = *(const u32x2*)(wsKm + (size_t)m * 1024 + h * 256 + 4 * lane);
            const f32x4 qv = (f32x4){bflo(qw.x), bfhi(qw.x), bflo(qw.y), bfhi(qw.y)}, kv = (f32x4){bflo(kw.x), bfhi(kw.x), bflo(kw.y), bfhi(kw.y)};
            const f32x4 nv = *(const f32x4*)(args.in[I_SMN] + (size_t)u * 256 + 4 * lane);
            const float qk = wave_sum((qv[0] * kv[0] + qv[1] * kv[1]) + (qv[2] * kv[2] + qv[3] * kv[3]));
            const float nq = wave_sum((qv[0] * nv[0] + qv[1] * nv[1]) + (qv[2] * nv[2] + qv[3] * nv[3]));
            const float s = qk * sd, den = wi * nq + s, dn = fmaxf(fabsf(den), __expf(-mt));
            if (wave == 0) { *(f32x4*)(out + O_SN + (size_t)u * 256 + 4 * lane) = wi * nv + sd * kv; if (lane == 0) out[O_SM + u] = mt; }
            const float* Cs = args.in[I_SMC_] + (size_t)u * 65536; float* Co = out + O_SC + (size_t)u * 65536;
            float pc[32];
            const bf16_t* vrow = wsZ + (size_t)m * NZ + OFF_MV + h * 256 + 32 * wave;
#pragma unroll
            for (int r = 0; r < 32; ++r) {
                const int v = 32 * wave + r;
                const f32x4 c4 = __builtin_nontemporal_load((const f32x4*)(Cs + (size_t)v * 256 + 4 * lane));
                const float vv = bf2f(vrow[r]);
                pc[r] = (c4[0] * qv[0] + c4[1] * qv[1]) + (c4[2] * qv[2] + c4[3] * qv[3]);
                __builtin_nontemporal_store(wi * c4 + (sd * vv) * kv, (f32x4*)(Co + (size_t)v * 256 + 4 * lane));
            }
            reduce32(pc, lane);
            float hsq = 0.f;
            { const float vv = bf2f(vrow[lane >> 1]); const float hval = (wi * pc[0] + s * vv) / dn;
              if ((lane & 1) == 0) { hv[32 * wave + (lane >> 1)] = hval; hsq = hval * hval; } }
            hsq = wave_sum(hsq);
            if (lane == 0) red[wave] = hsq;
            __syncthreads();
            if (tid < 256) {
                float tot = 0.f;
#pragma unroll
                for (int w = 0; w < 8; ++w) tot += red[w];
                const float rstd = rsqrtf(tot * (1.f / 256.f) + EPS);
                const float og = bf2f(wsZ[(size_t)m * NZ + OFF_MO + h * 256 + tid]);
                wsY[(size_t)m * D + 1024 + h * 256 + tid] = (bf16_t)f2bf(hv[tid] * rstd * args.in[I_GML][tid] * sigmoidf_(og));
            }
        }
        }
        __syncthreads();
    }
    SEAM(5);

    REP(6) if (IN(6)) { PH_IDS
        for (int u = bid; u < 256; u += G) {
            const int bh = u >> 4, c = u & 15, b = bh >> 2, h = bh & 3, m0 = b * TT + c * 128;
            LAS float* ev = misc; LAS float* bb = misc + 128; LAS float* pmx = misc + 256; LAS float* nin = misc + 384;
            LAS unsigned char* Vl = lds;
            __syncthreads();
            if (tid < 128) { ev[tid] = wsGATES[(size_t)(m0 + tid) * 8 + h] + args.in[I_BI][h]; bb[tid] = logsigmoid_(wsGATES[(size_t)(m0 + tid) * 8 + 4 + h] + args.in[I_BF][h]); }
            if (tid >= 256) nin[tid - 256] = wsNIN[(size_t)u * 256 + tid - 256];
            __syncthreads();
            if (wave == 0) {
                const float x0 = bb[2 * lane], x1 = bb[2 * lane + 1], loc = x0 + x1; float inc = loc;
#pragma unroll
                for (int o = 1; o < 64; o <<= 1) { const float t = __shfl_up(inc, o); if (lane >= o) inc += t; }
                const float b0 = inc - x1, b1 = inc, e0 = ev[2 * lane] - b0, e1 = ev[2 * lane + 1] - b1;
                float im = fmaxf(e0, e1);
#pragma unroll
                for (int o = 1; o < 64; o <<= 1) { const float t = __shfl_up(im, o); if (lane >= o) im = fmaxf(im, t); }
                float ex = __shfl_up(im, 1); if (lane == 0) ex = -INFINITY;
                bb[2 * lane] = b0; bb[2 * lane + 1] = b1; ev[2 * lane] = e0; ev[2 * lane + 1] = e1;
                pmx[2 * lane] = fmaxf(ex, e0); pmx[2 * lane + 1] = im;
            }
            for (int idx = tid; idx < 128 * 32; idx += 512) { const int s = idx >> 5, ch = idx & 31;
                *(LAS u32x4*)(Vl + s * 528 + ch * 16) = *(const u32x4*)(wsZ + (size_t)(m0 + s) * NZ + OFF_MV + h * 256 + ch * 8); }
            __syncthreads();
            const float mc = wsMINB[u];
            const int fr = lane & 15, g4 = lane >> 4, q = fr >> 2, p = fr & 3, t = 16 * wave + fr;
            const bf16_t* qp = wsQm + (size_t)(m0 + t) * 1024 + h * 256 + 8 * g4;
            f32x4 sacc[8];
#pragma unroll
            for (int st = 0; st < 8; ++st) sacc[st] = (f32x4){0.f, 0.f, 0.f, 0.f};
#pragma unroll 2
            for (int ks = 0; ks < 8; ++ks) {
                const bf16x8 qf = ld8(qp + 32 * ks);
                const bf16_t* kp = wsKm + (size_t)(m0 + fr) * 1024 + h * 256 + 32 * ks + 8 * g4;
#pragma unroll
                for (int st = 0; st < 8; ++st) if (st <= wave) { const bf16x8 xk = ld8(kp + (size_t)(16 * st) * 1024); sacc[st] = MFMA16(xk, qf, sacc[st]); }
            }
            const float Mt = fmaxf(mc, pmx[t]);
            float rs = 0.f;
#pragma unroll
            for (int st = 0; st < 8; ++st) { const f32x4 e4 = *(const LAS f32x4*)(ev + 16 * st + 4 * g4);
#pragma unroll
                for (int r = 0; r < 4; ++r) { const int s = 16 * st + 4 * g4 + r; const float pv = (s <= t) ? sacc[st][r] * __expf(e4[r] - Mt) : 0.f; sacc[st][r] = pv; rs += pv; } }
            float nq = 0.f;
            f32x4 oacc[16];
#pragma unroll
            for (int vt = 0; vt < 16; ++vt) oacc[vt] = (f32x4){0.f, 0.f, 0.f, 0.f};
            const bf16_t* cin = wsCIN + (size_t)u * 65536 + (size_t)fr * 256 + 8 * g4;
#pragma unroll 2
            for (int ks = 0; ks < 8; ++ks) {
                const bf16x8 qf = ld8(qp + 32 * ks);
                const f32x4 n0 = *(const LAS f32x4*)(nin + 32 * ks + 8 * g4), n1 = *(const LAS f32x4*)(nin + 32 * ks + 8 * g4 + 4);
                nq += (bf2f((unsigned short)qf[0]) * n0[0] + bf2f((unsigned short)qf[1]) * n0[1]) + (bf2f((unsigned short)qf[2]) * n0[2] + bf2f((unsigned short)qf[3]) * n0[3])
                    + (bf2f((unsigned short)qf[4]) * n1[0] + bf2f((unsigned short)qf[5]) * n1[1]) + (bf2f((unsigned short)qf[6]) * n1[2] + bf2f((unsigned short)qf[7]) * n1[3]);
#pragma unroll
                for (int vt = 0; vt < 16; ++vt) { const bf16x8 xc = ld8(cin + (size_t)(16 * vt) * 256 + 32 * ks); oacc[vt] = MFMA16(xc, qf, oacc[vt]); }
            }
            rs += __shfl_xor(rs, 16); rs += __shfl_xor(rs, 32); nq += __shfl_xor(nq, 16); nq += __shfl_xor(nq, 32);
            const float wi = __expf(mc - Mt), den = wi * nq + rs, dn = fmaxf(fabsf(den), __expf(-(bb[t] + Mt)));
#pragma unroll
            for (int vt = 0; vt < 16; ++vt) oacc[vt] = oacc[vt] * wi;
#pragma unroll
            for (int pb = 0; pb < 4; ++pb) if (2 * pb <= wave) {
                u32x4 pw; pw.x = pk2(sacc[2 * pb][0], sacc[2 * pb][1]); pw.y = pk2(sacc[2 * pb][2], sacc[2 * pb][3]); pw.z = pk2(sacc[2 * pb + 1][0], sacc[2 * pb + 1][1]); pw.w = pk2(sacc[2 * pb + 1][2], sacc[2 * pb + 1][3]);
                const bf16x8 yp = __builtin_bit_cast(bf16x8, pw);
                const int rb = (32 * pb + 4 * g4 + q) * 528 + 8 * p;
#pragma unroll
                for (int vt = 0; vt < 16; ++vt) { const bf16x8 xv = cat8(tr_read(Vl + rb + 32 * vt), tr_read(Vl + rb + 16 * 528 + 32 * vt)); oacc[vt] = MFMA16(xv, yp, oacc[vt]); }
            }
            const float inv = 1.f / dn; float ss = 0.f;
#pragma unroll
            for (int vt = 0; vt < 16; ++vt) { oacc[vt] = oacc[vt] * inv; ss += (oacc[vt][0] * oacc[vt][0] + oacc[vt][1] * oacc[vt][1]) + (oacc[vt][2] * oacc[vt][2] + oacc[vt][3] * oacc[vt][3]); }
            ss += __shfl_xor(ss, 16); ss += __shfl_xor(ss, 32);
            const float rstd = rsqrtf(ss * (1.f / 256.f) + EPS);
#pragma unroll
            for (int vt = 0; vt < 16; ++vt) {
                const int v0 = 16 * vt + 4 * g4; const f32x4 gg = *(const f32x4*)(args.in[I_GML] + v0);
                const u32x2 ow = *(const u32x2*)(wsZ + (size_t)(m0 + t) * NZ + OFF_MO + h * 256 + v0);
                const float o0 = oacc[vt][0] * rstd * gg[0] * sigmoidf_(bflo(ow.x)), o1 = oacc[vt][1] * rstd * gg[1] * sigmoidf_(bfhi(ow.x));
                const float o2 = oacc[vt][2] * rstd * gg[2] * sigmoidf_(bflo(ow.y)), o3 = oacc[vt][3] * rstd * gg[3] * sigmoidf_(bfhi(ow.y));
                u32x2 w; w.x = pk2(o0, o1); w.y = pk2(o2, o3); *(u32x2*)(wsY + (size_t)(m0 + t) * D + 1024 + h * 256 + v0) = w;
            }
        }
        __syncthreads();
    }
    SEAM(6);

    REP(7) if (IN(7)) { PH_IDS
        { const pg8::Gemm g = pg8::mk_gemm(wsY, wsWoutT, D * 2, D * 2, D, 0); pg8::StaticOrder S; S.init(32, 8, G, bid);
          EpiResNorm<float> E{args.in[I_XP], wsX1, wsXN, args.in[I_GX], wsSS}; pg8::gemm_phase<EpiResNorm<float>, true, true>(lds, g, S, E, wave); }
        skinny_gemm(wsY + (size_t)MP * D, D, wsWoutT, D, D, D, 1, 0, 64, MP, FResNorm<float>{args.in[I_XS], MP, wsX1, wsXN, args.in[I_GX], wsSS}, 0, wave, (LAS float*)lds);
        if (bid >= 64) { convert_matrix(args.in[I_WCQ], D, D, D, wsWcqT, D, (LAS float*)(lds + wave * 16384), (bid - 64) * 8 + wave, (G - 64) * 8, lane);
                         convert_matrix(args.in[I_WCO], D, D, D, wsWcoT, D, (LAS float*)(lds + wave * 16384), (bid - 64) * 8 + wave, (G - 64) * 8, lane); }
    }
    SEAM(7);

    REP(9) if (IN(9)) { PH_IDS
        const float qs = 0.04419417382415922f;
        { const pg8::Gemm g = pg8::mk_gemm(wsXN, wsWcqT, D * 2, D * 2, D, 0); pg8::StaticOrder S; S.init(32, 8, G, bid);
          pg8::EpiF8<FStoreBf16> E{{wsQC, D, qs, 0, wsSS}}; pg8::gemm_phase<pg8::EpiF8<FStoreBf16>, true, true>(lds, g, S, E, wave); }
        skinny_gemm(wsXN + (size_t)MP * D, D, wsWcqT, D, D, D, 1, 0, 64, MP, FStoreBf16{wsQC, D, qs, 0, wsSS}, 0, wave, (LAS float*)lds);
        if (bid >= 64) convert_matrix(args.in[I_WUP], DFF, D, DFF, wsWupT, D, (LAS float*)(lds + wave * 16384), (bid - 64) * 8 + wave, (G - 64) * 8, lane);
    }
    SEAM(9);

    REP(10) if (IN(10)) { PH_IDS
        { pg8::Gemm g{(const char*)wsQC, (const char*)wsMK, D * 2, D * 2, 512, (size_t)256 * D * 2, 0, 1024, 1024, (size_t)256 * D * 2, 0x7fffffff, 0x7fffffff, 0, 0}; pg8::StaticOrder S; S.init(32, 4, G, bid);
          EpiSoftmax E{wsPB, misc}; pg8::gemm_phase<EpiSoftmax, true, true>(lds, g, S, E, wave); }
        { pg8::Gemm g{(const char*)wsWcoT, (const char*)wsMVt, D * 2, D * 2, 512, (size_t)256 * D * 2, 0, 1024, 1024, 0, 3, 3, 2, (size_t)256 * D * 2}; pg8::StaticOrder S; S.init(8, 16, G, bid - 128);
          pg8::EpiF8<FVw> E{{wsVW}}; pg8::gemm_phase<pg8::EpiF8<FVw>, true, true>(lds, g, S, E, wave); }
        for (int u = bid; u < 512; u += G) {
            const int sb = u >> 2, h = u & 3, m = MP + sb;
            LAS float* scr = misc;
            LAS float* part = (LAS float*)lds;
            __syncthreads();
            const u32x2 qa = *(const u32x2*)(wsQC + (size_t)m * D + h * 512 + 4 * lane), qb = *(const u32x2*)(wsQC + (size_t)m * D + h * 512 + 256 + 4 * lane);
            const f32x4 q0 = (f32x4){bflo(qa.x), bfhi(qa.x), bflo(qa.y), bfhi(qa.y)}, q1 = (f32x4){bflo(qb.x), bfhi(qb.x), bflo(qb.y), bfhi(qb.y)};
            const float* kb = args.in[I_CK] + ((size_t)sb * 256 * 4 + h) * 512 + 4 * lane + (size_t)(32 * wave) * 2048;
            const float* vb = args.in[I_CV] + ((size_t)sb * 256 * 4 + h) * 512 + 4 * lane + (size_t)(32 * wave) * 2048;
            float pa[32];
#pragma unroll
            for (int i = 0; i < 32; ++i) { const f32x4 a = __builtin_nontemporal_load((const f32x4*)(kb + (size_t)i * 2048)), c4 = __builtin_nontemporal_load((const f32x4*)(kb + (size_t)i * 2048 + 256));
                pa[i] = ((a[0] * q0[0] + a[1] * q0[1]) + (a[2] * q0[2] + a[3] * q0[3])) + ((c4[0] * q1[0] + c4[1] * q1[1]) + (c4[2] * q1[2] + c4[3] * q1[3])); }
            reduce32(pa, lane);
            if ((lane & 1) == 0) scr[32 * wave + (lane >> 1)] = pa[0];
            __syncthreads();
            const f32x4 s4 = *(const LAS f32x4*)(scr + 4 * lane);
            const float mx = wave_max(fmaxf(fmaxf(s4[0], s4[1]), fmaxf(s4[2], s4[3])));
            const float sm = wave_sum((__expf(s4[0] - mx) + __expf(s4[1] - mx)) + (__expf(s4[2] - mx) + __expf(s4[3] - mx)));
            const float inv = 1.f / sm;
            f32x4 o0 = (f32x4){0.f, 0.f, 0.f, 0.f}, o1 = (f32x4){0.f, 0.f, 0.f, 0.f};
#pragma unroll 16
            for (int i = 0; i < 32; ++i) { const float pr = __expf(scr[32 * wave + i] - mx) * inv;
                const f32x4 a = __builtin_nontemporal_load((const f32x4*)(vb + (size_t)i * 2048)), c4 = __builtin_nontemporal_load((const f32x4*)(vb + (size_t)i * 2048 + 256));
                o0 = o0 + pr * a; o1 = o1 + pr * c4; }
            *(LAS f32x4*)(part + wave * 512 + 4 * lane) = o0; *(LAS f32x4*)(part + wave * 512 + 256 + 4 * lane) = o1;
            __syncthreads();
            float tot = 0.f;
#pragma unroll
            for (int w = 0; w < 8; ++w) tot += part[w * 512 + tid];
            wsOC[(size_t)m * D + h * 512 + tid] = (bf16_t)f2bf(tot);
        }
        __syncthreads();
    }
    SEAM(10);

    REP(11) if (IN(11)) { PH_IDS
        { pg8::Gemm g{(const char*)wsPB, (const char*)wsVW, 2048, 2048, 1024, (size_t)256 * 2048, 0, 0, (size_t)256 * 2048, (size_t)D * 2048, 0x7fffffff, 0x7fffffff, 0, 0}; pg8::StaticOrder S; S.init(32, 8, G, bid);
          EpiResNorm<bf16_t> E{wsX1, wsX2, wsXN, args.in[I_GFFN], wsSS + MT}; pg8::gemm_phase<EpiResNorm<bf16_t>, true, true>(lds, g, S, E, wave); }
        skinny_gemm(wsOC + (size_t)MP * D, D, wsWcoT, D, D, D, 1, 0, 64, MP, FResNorm<bf16_t>{wsX1, 0, wsX2, wsXN, args.in[I_GFFN], wsSS + MT}, 0, wave, (LAS float*)lds);
        if (bid >= 64) convert_matrix(args.in[I_WDN], D, DFF, D, wsWdnT, DFF, (LAS float*)(lds + wave * 16384), (bid - 64) * 8 + wave, (G - 64) * 8, lane);
    }
    SEAM(11);

    REP(13) if (IN(13)) { PH_IDS
        { const pg8::Gemm g = pg8::mk_gemm(wsXN, wsWupT, D * 2, D * 2, D, 0); pg8::StaticOrder S; S.init(32, 32, G, bid);
          pg8::EpiF8<FStoreBf16> E{{wsU, DFF, 1.f, 1, wsSS + MT}}; pg8::gemm_phase<pg8::EpiF8<FStoreBf16>, true, true>(lds, g, S, E, wave); }
        skinny_gemm(wsXN + (size_t)MP * D, D, wsWupT, D, D, DFF, 1, 0, 256, MP, FStoreBf16{wsU, DFF, 1.f, 1, wsSS + MT}, 0, wave, (LAS float*)lds);
    }
    SEAM(13);

    REP(14) if (IN(14)) { PH_IDS
        { const pg8::Gemm g = pg8::mk_gemm(wsU, wsWdnT, DFF * 2, DFF * 2, DFF, 0); pg8::StaticOrder S; S.init(32, 8, G, bid);
          pg8::EpiF8<FResB> E{{wsX2, wsX1}}; pg8::gemm_phase<pg8::EpiF8<FResB>, true, true>(lds, g, S, E, wave); }
        skinny_gemm(wsU + (size_t)MP * DFF, DFF, wsWdnT, DFF, DFF, D, 4, 0, 256, 0, FPart{wsPART, D}, 128, wave, (LAS float*)lds);
    }
    SEAM(14);

    REP(15) if (IN(15)) { PH_IDS
        f32x4 gfin[8]; load_gain(args.in[I_GFIN], lane, gfin);
        for (int m = gw; m < MT; m += NGW) {
            f32x4 v[8]; float ss = 0.f;
#pragma unroll
            for (int j = 0; j < 8; ++j) {
                if (m < MP) v[j] = ld4_res(wsX1 + (size_t)m * D + 256 * j + 4 * lane);
                else { const size_t o = (size_t)(m - MP) * D + 256 * j + 4 * lane; v[j] = ld4_res(wsX2 + (size_t)m * D + 256 * j + 4 * lane);
#pragma unroll
                    for (int s = 0; s < 4; ++s) v[j] = v[j] + *(const f32x4*)(wsPART + (size_t)s * 128 * D + o); }
                ss += (v[j][0] * v[j][0] + v[j][1] * v[j][1]) + (v[j][2] * v[j][2] + v[j][3] * v[j][3]);
            }
            const float rstd = rsqrtf(wave_sum(ss) * (1.f / D) + EPS);
            float* o = (m < MP) ? out + O_YP + (size_t)m * D : out + O_YS + (size_t)(m - MP) * D;
#pragma unroll
            for (int j = 0; j < 8; ++j) __builtin_nontemporal_store(v[j] * rstd * gfin[j], (f32x4*)(o + 256 * j + 4 * lane));
        }
    }
#undef IN
#undef SEAM
}

extern "C" void kernel_launch(void* const* d_in, const int* in_sizes, int n_in, void* d_out, int out_size, void* d_ws, size_t ws_size, hipStream_t stream) {
    static int grid = 0;
    if (grid == 0) {
        int dev = 0, cus = 0, per_cu = 0;
        if (n_in != 39 || ws_size < WS_END) { fprintf(stderr, "kernel_launch: unexpected n_in %d / ws %zu\n", n_in, ws_size); grid = -1; return; }
        hipGetDevice(&dev);
        hipDeviceGetAttribute(&cus, hipDeviceAttributeMultiprocessorCount, dev);
        if (hipFuncSetAttribute((const void*)mega_fwd, hipFuncAttributeMaxDynamicSharedMemorySize, LDS_BYTES) != hipSuccess) { fprintf(stderr, "kernel_launch: hipFuncSetAttribute failed\n"); grid = -1; return; }
        if (hipOccupancyMaxActiveBlocksPerMultiprocessor(&per_cu, (const void*)mega_fwd, 512, LDS_BYTES) != hipSuccess || per_cu < 1) { fprintf(stderr, "kernel_launch: occupancy query says %d\n", per_cu); per_cu = 1; }
        (void)hipGetLastError();
        grid = cus;
    }
    if (grid < 0) return;
    Args a{};
    for (int i = 0; i < 39; ++i) a.in[i] = (const float*)d_in[i];
    a.out = (float*)d_out; a.ws = (unsigned char*)d_ws; a.ph_lo = 0; a.ph_hi = NPH;
    if (hipMemsetAsync((char*)d_ws + WS_CTL, 0, 65536, stream) != hipSuccess) { fprintf(stderr, "kernel_launch: memset failed\n"); return; }
    hipLaunchKernelGGL(mega_fwd, dim3(grid), dim3(512), LDS_BYTES, stream, a);
    hipError_t e = hipPeekAtLastError();
    if (e != hipSuccess) fprintf(stderr, "kernel_launch: launch failed: %s (grid %d)\n", hipGetErrorString(e), grid);
}
```

```cpp
#include <hip/hip_runtime.h>
#include <cstdio>
#include <cstdint>

#define LAS __attribute__((address_space(3)))
typedef unsigned short bf16_t;
typedef short bf16x8 __attribute__((ext_vector_type(8)));
typedef short s16x4 __attribute__((ext_vector_type(4)));
typedef float f32x4 __attribute__((ext_vector_type(4)));
typedef float f32x2 __attribute__((ext_vector_type(2)));
typedef unsigned u32x4 __attribute__((ext_vector_type(4)));
typedef unsigned u32x2 __attribute__((ext_vector_type(2)));

constexpr int D = 2048, NB = 4, TT = 2048, MP = NB * TT, MS = 128, MT = MP + MS;
constexpr int DIN = 5128, NZ = 5120, NZP = 5376, DR = 1024, DFF = 8192, NMEM = 256, MMEM = NB * NMEM;
constexpr float EPS = 1e-6f;
constexpr int OFF_RX = 0, OFF_RG = 1024, OFF_MU = 2048, OFF_MV = 3072, OFF_MO = 4096;
constexpr size_t O_YP = 0;
constexpr size_t O_YS = O_YP + (size_t)MP * D;
constexpr size_t O_PH = O_YS + (size_t)MS * D;
constexpr size_t O_PRC = O_PH + 4 * 1024;
constexpr size_t O_PC = O_PRC + 4 * 3 * 1024;
constexpr size_t O_PN = O_PC + (size_t)4 * 4 * 65536;
constexpr size_t O_PM = O_PN + 4 * 4 * 256;
constexpr size_t O_PMC = O_PM + 16;
constexpr size_t O_PK = O_PMC + 4 * 3 * 1024;
constexpr size_t O_PV = O_PK + (size_t)MMEM * D;
constexpr size_t O_SH = O_PV + (size_t)MMEM * D;
constexpr size_t O_SRC = O_SH + 128 * 1024;
constexpr size_t O_SC = O_SRC + 128 * 3 * 1024;
constexpr size_t O_SN = O_SC + (size_t)128 * 4 * 65536;
constexpr size_t O_SM = O_SN + 128 * 4 * 256;
constexpr size_t O_SMC = O_SM + 512;
constexpr size_t MiB = 1u << 20;
constexpr size_t WS_WIN = 0, WS_WOUT = 20 * MiB, WS_WCQ = 28 * MiB, WS_WMK = 36 * MiB, WS_WMV = 44 * MiB, WS_WCO = 52 * MiB;
constexpr size_t WS_WUP = 60 * MiB, WS_WDN = 92 * MiB, WS_WG = 124 * MiB, WS_WQK = 125 * MiB, WS_XN = 126 * MiB, WS_MN = 159 * MiB;
constexpr size_t WS_Z = 163 * MiB, WS_GATES = 245 * MiB, WS_XC = 246 * MiB, WS_UC = 263 * MiB, WS_AU = 280 * MiB, WS_QM = 345 * MiB;
constexpr size_t WS_KM = 362 * MiB, WS_Y = 379 * MiB, WS_X1 = 412 * MiB, WS_X2 = 477 * MiB, WS_QC = 542 * MiB, WS_OC = 575 * MiB;
constexpr size_t WS_MK = 608 * MiB, WS_MVT = 612 * MiB, WS_U = 616 * MiB, WS_CLOC = 746 * MiB, WS_CIN = 778 * MiB, WS_NLOC = 810 * MiB;
constexpr size_t WS_NIN = 811 * MiB, WS_MSTAT = 812 * MiB, WS_SUM = 813 * MiB, WS_PART = 815 * MiB, WS_CTL = 819 * MiB, WS_WIN2 = 820 * MiB, WS_END = 842 * MiB;
constexpr int LDS_BYTES = 147712, MISC_OFF = 139264;
constexpr int NPH = 16;

__device__ __forceinline__ unsigned f2bf(float f) { unsigned u = __builtin_bit_cast(unsigned, f); return (u + 0x7fffu + ((u >> 16) & 1u)) >> 16; }
__device__ __forceinline__ unsigned pk2(float lo, float hi) { return f2bf(lo) | (f2bf(hi) << 16); }
__device__ __forceinline__ float bf2f(unsigned h) { return __builtin_bit_cast(float, (h & 0xffffu) << 16); }
__device__ __forceinline__ float bflo(unsigned w) { return __builtin_bit_cast(float, w << 16); }
__device__ __forceinline__ float bfhi(unsigned w) { return __builtin_bit_cast(float, w & 0xffff0000u); }
__device__ __forceinline__ float wave_sum(float v) {
#pragma unroll
    for (int o = 1; o < 64; o <<= 1) v += __shfl_xor(v, o);
    return v;
}
__device__ __forceinline__ float wave_max(float v) {
#pragma unroll
    for (int o = 1; o < 64; o <<= 1) v = fmaxf(v, __shfl_xor(v, o));
    return v;
}
__device__ __forceinline__ void reduce32(float (&a)[32], int lane) {
#pragma unroll
    for (int i = 0; i < 16; ++i) { const bool up = lane & 32; const float keep = up ? a[i + 16] : a[i], send = up ? a[i] : a[i + 16]; a[i] = keep + __shfl_xor(send, 32); }
#pragma unroll
    for (int i = 0; i < 8; ++i) { const bool up = lane & 16; const float keep = up ? a[i + 8] : a[i], send = up ? a[i] : a[i + 8]; a[i] = keep + __shfl_xor(send, 16); }
#pragma unroll
    for (int i = 0; i < 4; ++i) { const bool up = lane & 8; const float keep = up ? a[i + 4] : a[i], send = up ? a[i] : a[i + 4]; a[i] = keep + __shfl_xor(send, 8); }
#pragma unroll
    for (int i = 0; i < 2; ++i) { const bool up = lane & 4; const float keep = up ? a[i + 2] : a[i], send = up ? a[i] : a[i + 2]; a[i] = keep + __shfl_xor(send, 4); }
    { const bool up = lane & 2; const float keep = up ? a[1] : a[0], send = up ? a[0] : a[1]; a[0] = keep + __shfl_xor(send, 2); }
    a[0] += __shfl_xor(a[0], 1);
}
__device__ __forceinline__ float sigmoidf_(float x) { return 1.f / (1.f + __expf(-x)); }
__device__ __forceinline__ float gelu_tanh(float x) { const float u = 0.7978845608028654f * (x + 0.044715f * x * x * x); return 0.5f * x * (1.f + tanhf(u)); }
__device__ __forceinline__ float logsigmoid_(float x) { return fminf(x, 0.f) - log1pf(__expf(-fabsf(x))); }
__device__ __forceinline__ bf16x8 ld8(const bf16_t* p) { return *(const bf16x8*)p; }
__device__ __forceinline__ s16x4 tr_read(const LAS unsigned char* p) {
    typedef short v4i16_t __attribute__((ext_vector_type(4)));
    return __builtin_bit_cast(s16x4, __builtin_amdgcn_ds_read_tr16_b64_v4i16((LAS v4i16_t*)p));
}
__device__ __forceinline__ bf16x8 cat8(s16x4 a, s16x4 b) { return (bf16x8){a[0], a[1], a[2], a[3], b[0], b[1], b[2], b[3]}; }
__device__ __forceinline__ int lane_id() { int l; asm volatile("v_mbcnt_lo_u32_b32 %0, -1, 0\n\tv_mbcnt_hi_u32_b32 %0, -1, %0" : "=v"(l)); return l; }
#define MFMA16(x, y, c) __builtin_amdgcn_mfma_f32_16x16x32_bf16((x), (y), (c), 0, 0, 0)

namespace pg8 {
constexpr int BM = 256, BK = 64, HALF = 128, HTB = HALF * BK * 2, STAGE_BYTES = 8 * HTB, NXCD = 8, WGM = 8;
__host__ __device__ __forceinline__ int lds_byte(int r, int c) { const int st = (r >> 4) * 2 + (c >> 5), rr = r & 15, cc = c & 31, ob = rr * 64 + cc * 2; return st * 1024 + (ob ^ (((ob >> 9) & 1) << 5)); }
__host__ __device__ __forceinline__ void stage_rc(int b, int& R, int& C) { const int st = b / 1024, sb = b % 1024, swz = sb ^ (((sb >> 9) & 1) << 5); R = (st >> 1) * 16 + swz / 64; C = (st & 1) * 32 + (swz % 64) / 2; }
__host__ __device__ __forceinline__ int perm32(int rho) { const int n = rho >> 4, i = rho & 15; return 8 * (i >> 2) + 4 * n + (i & 3); }
struct Unit { int pm, pn; };
struct Gemm { const char* A; const char* B; int lda, ldb  , K; size_t a_pm; int a_sh; size_t a_pn, b_pn, b_pm8; int a_msk, b_msk, b_sh2; size_t b_pn2; };
__device__ __forceinline__ Gemm mk_gemm(const void* A, const void* B, int lda, int ldb, int K, int acs) { return Gemm{(const char*)A, (const char*)B, lda, ldb, K, (size_t)256 * lda, 1, (size_t)acs, (size_t)256 * ldb, 0, 0x7fffffff, 0x7fffffff, 0, 0}; }
struct StaticOrder {
    int nM, nN, nwg, G, c;
    __device__ void init(int nM_, int nN_, int G_, int c_) { nM = nM_; nN = nN_; nwg = nM * nN; G = G_; c = c_; }
    __device__ bool next(int i, Unit& u) const {
        if (c < 0 || c >= G) return false;
        const long L = (long)i * G + c; if (L >= nwg) return false;
        int wgid = (int)L; { const int q = nwg / NXCD, r = nwg % NXCD, xcd = wgid % NXCD, off = wgid / NXCD; wgid = (xcd < r ? xcd * (q + 1) : r * (q + 1) + (xcd - r) * q) + off; }
        const int nig = WGM * nN, gid = wgid / nig, fm = gid * WGM, gsz = (nM - fm) < WGM ? (nM - fm) : WGM;
        u.pm = fm + ((wgid % nig) % gsz); u.pn = (wgid % nig) / gsz; return true;
    }
};
template <class F> struct EpiF8 {
    static constexpr bool PERM = true;
    F f;
    __device__ __forceinline__ void operator()(const f32x4 (&acc)[2][2][4][2], const Unit& u, int wr, int wc, int fr, int fq) const {
        float rs[2][4];
#pragma unroll
        for (int ai = 0; ai < 2; ++ai)
#pragma unroll
            for (int m = 0; m < 4; ++m) rs[ai][m] = f.rowscale(u.pm * BM + ai * HALF + wr * 64 + m * 16 + fr);
#pragma unroll
        for (int ai = 0; ai < 2; ++ai)
#pragma unroll
            for (int m = 0; m < 4; ++m) {
                const int row = u.pm * BM + ai * HALF + wr * 64 + m * 16 + fr;
#pragma unroll
                for (int bj = 0; bj < 2; ++bj) f.f8(row, u.pn * BM + bj * HALF + wc * 32 + 8 * fq, acc[ai][bj][m][0] * rs[ai][m], acc[ai][bj][m][1] * rs[ai][m]);
            }
    }
};
template <class F> struct EpiF {
    static constexpr bool PERM = false;
    F f;
    __device__ __forceinline__ void operator()(const f32x4 (&acc)[2][2][4][2], const Unit& u, int wr, int wc, int fr, int fq) const {
        float rs[2][4];
#pragma unroll
        for (int ai = 0; ai < 2; ++ai)
#pragma unroll
            for (int m = 0; m < 4; ++m) rs[ai][m] = f.rowscale(u.pm * BM + ai * HALF + wr * 64 + m * 16 + fr);
#pragma unroll
        for (int ai = 0; ai < 2; ++ai)
#pragma unroll
            for (int m = 0; m < 4; ++m) {
                const int row = u.pm * BM + ai * HALF + wr * 64 + m * 16 + fr;
#pragma unroll
                for (int bj = 0; bj < 2; ++bj)
#pragma unroll
                    for (int n = 0; n < 2; ++n) f(row, u.pn * BM + bj * HALF + wc * 32 + n * 16 + 4 * fq, acc[ai][bj][m][n] * rs[ai][m]);
            }
    }
};

template <class Epi, bool ALIGN_EPI, bool SP2>
__device__ __forceinline__ void gemm_phase(LAS unsigned char* lds, const Gemm g, const StaticOrder& S, const Epi& E, const int wid) {
    const int lane = lane_id(), tid = wid * 64 + lane, wr = wid >> 2, wc = wid & 3, fr = lane & 15, fq = lane >> 4;
    const int K = g.K, nt = K / BK;
    unsigned voffA[2], voffB[2];
#pragma unroll
    for (int i = 0; i < 2; ++i) { int R, C; stage_rc(tid * 16 + i * 8192, R, C); const int Rb = Epi::PERM ? ((R & ~31) + perm32(R & 31)) : R; voffA[i] = (unsigned)(R * g.lda + C * 2); voffB[i] = (unsigned)(Rb * g.ldb + C * 2); }
    const size_t kstep = (size_t)(BK * 2);
    const size_t hstepA = (size_t)HALF * g.lda, hstepB = (size_t)HALF * g.ldb;
    const unsigned ldsw = (unsigned)wid * 1024u;
    const int aoff = lds_byte(wr * 64 + fr, fq * 8), boff = lds_byte(wc * 32 + fr, fq * 8);
#define PG8_SA(b, h) (((b) * 2 + (h)) * HTB)
#define PG8_SB(b, h) ((4 + (b) * 2 + (h)) * HTB)
#define PG8_STAGE(bufoff, gbase, voff) do { _Pragma("unroll") for (int _i = 0; _i < 2; ++_i) \
        __builtin_amdgcn_global_load_lds((const unsigned*)((const char*)(gbase) + (voff)[_i]), (LAS unsigned*)(lds + (bufoff) + ldsw + _i * 8192), 16, 0, 0); } while (0)
#define PG8_LDA(dst, b, h) do { _Pragma("unroll") for (int m = 0; m < 4; ++m) _Pragma("unroll") for (int k = 0; k < 2; ++k) dst[m][k] = *(const LAS bf16x8*)(lds + PG8_SA(b, h) + aoff + m * 2048 + k * 1024); } while (0)
#define PG8_LDB(dst, b, h) do { _Pragma("unroll") for (int n = 0; n < 2; ++n) _Pragma("unroll") for (int k = 0; k < 2; ++k) dst[n][k] = *(const LAS bf16x8*)(lds + PG8_SB(b, h) + boff + n * 2048 + k * 1024); } while (0)
#define PG8_MMA(ai, bj, At, Bt) do { __builtin_amdgcn_s_setprio(1); _Pragma("unroll") for (int m = 0; m < 4; ++m) _Pragma("unroll") for (int n = 0; n < 2; ++n) _Pragma("unroll") for (int k = 0; k < 2; ++k) \
        acc[ai][bj][m][n] = __builtin_amdgcn_mfma_f32_16x16x32_bf16(Bt[n][k], At[m][k], acc[ai][bj][m][n], 0, 0, 0); __builtin_amdgcn_s_setprio(0); } while (0)
#define PG8_WAIT_V(n) asm volatile("s_waitcnt vmcnt(" #n ")" ::: "memory")
#define PG8_WAIT_L(n) asm volatile("s_waitcnt lgkmcnt(" #n ")" ::: "memory")
#define PG8_BAR __builtin_amdgcn_s_barrier()
#define PG8_SCHED __builtin_amdgcn_sched_barrier(0)
#define PG8_APTR(u) (g.A + (size_t)(u).pm * g.a_pm + (size_t)(((u).pn >> g.a_sh) & g.a_msk) * g.a_pn)
#define PG8_BPTR(u) (g.B + (size_t)((u).pn & g.b_msk) * g.b_pn + (size_t)((u).pn >> g.b_sh2) * g.b_pn2 + (size_t)((u).pm >> 3) * g.b_pm8)
    Unit cur, nxt; int ui = 0;
    if (!S.next(0, cur)) return;
    f32x4 acc[2][2][4][2];
#pragma unroll
    for (int a = 0; a < 2; ++a)
#pragma unroll
        for (int b = 0; b < 2; ++b)
#pragma unroll
            for (int m = 0; m < 4; ++m)
#pragma unroll
                for (int n = 0; n < 2; ++n) acc[a][b][m][n] = (f32x4){0.f, 0.f, 0.f, 0.f};
    bf16x8 At[4][2], B0[2][2], B1[2][2];
    const char* cA = PG8_APTR(cur); const char* cB = PG8_BPTR(cur);
    if constexpr (SP2) {
        PG8_STAGE(PG8_SB(0, 0), cB, voffB); PG8_STAGE(PG8_SB(0, 1), cB + hstepB, voffB); PG8_STAGE(PG8_SA(0, 0), cA, voffA); PG8_STAGE(PG8_SA(0, 1), cA + hstepA, voffA);
        if (wr == 1) PG8_BAR;
        PG8_WAIT_V(2); PG8_BAR;
        PG8_STAGE(PG8_SB(1, 0), cB + kstep, voffB); PG8_STAGE(PG8_SA(1, 0), cA + kstep, voffA); PG8_STAGE(PG8_SB(1, 1), cB + hstepB + kstep, voffB);
        PG8_WAIT_V(6); PG8_BAR;
    } else {
        PG8_STAGE(PG8_SB(0, 0), cB, voffB); PG8_STAGE(PG8_SA(0, 0), cA, voffA); PG8_STAGE(PG8_SB(0, 1), cB + hstepB, voffB); PG8_STAGE(PG8_SA(0, 1), cA + hstepA, voffA);
        if (wr == 1) PG8_BAR;
        PG8_WAIT_V(4); PG8_BAR;
        PG8_STAGE(PG8_SB(1, 0), cB + kstep, voffB); PG8_STAGE(PG8_SA(1, 0), cA + kstep, voffA); PG8_STAGE(PG8_SB(1, 1), cB + hstepB + kstep, voffB);
        PG8_WAIT_V(6); PG8_BAR;
    }
    for (;;) {
        const bool has_next = S.next(ui + 1, nxt);
        const char* nA = has_next ? PG8_APTR(nxt) : cA; const char* nB = has_next ? PG8_BPTR(nxt) : cB;
#pragma nounroll
        for (int t = 0; t < nt; t += 2) {
            const bool last = (t == nt - 2);
            const char* a1 = cA + (size_t)(t + 1) * kstep;
            const char* a2 = last ? nA : cA + (size_t)(t + 2) * kstep; const char* b2 = last ? nB : cB + (size_t)(t + 2) * kstep;
            const char* a3 = a2 + kstep; const char* b3 = b2 + kstep;
            if constexpr (SP2) {
            PG8_LDB(B0, 0, 0); PG8_LDB(B1, 0, 1); PG8_SCHED; PG8_LDA(At, 0, 0); PG8_STAGE(PG8_SA(1, 1), a1 + hstepA, voffA);
            PG8_WAIT_V(8); PG8_WAIT_L(0); PG8_BAR; PG8_MMA(0, 0, At, B0); PG8_MMA(0, 1, At, B1); PG8_BAR; PG8_SCHED;
            PG8_LDA(At, 0, 1); PG8_STAGE(PG8_SB(0, 0), b2, voffB); PG8_STAGE(PG8_SB(0, 1), b2 + hstepB, voffB); PG8_STAGE(PG8_SA(0, 0), a2, voffA);
            PG8_WAIT_V(8); PG8_WAIT_L(0); PG8_BAR; PG8_MMA(1, 0, At, B0); PG8_MMA(1, 1, At, B1); PG8_BAR; PG8_SCHED;
            PG8_LDB(B0, 1, 0); PG8_LDB(B1, 1, 1); PG8_SCHED; PG8_LDA(At, 1, 0); PG8_STAGE(PG8_SA(0, 1), a2 + hstepA, voffA);
            PG8_WAIT_V(8); PG8_WAIT_L(0); PG8_BAR; PG8_MMA(0, 0, At, B0); PG8_MMA(0, 1, At, B1); PG8_BAR; PG8_SCHED;
            PG8_LDA(At, 1, 1); PG8_STAGE(PG8_SB(1, 0), b3, voffB); PG8_STAGE(PG8_SB(1, 1), b3 + hstepB, voffB); PG8_STAGE(PG8_SA(1, 0), a3, voffA);
            PG8_WAIT_V(8); PG8_WAIT_L(0); PG8_BAR; PG8_MMA(1, 0, At, B0); PG8_MMA(1, 1, At, B1); PG8_BAR; PG8_SCHED;
            } else {
            PG8_LDB(B0, 0, 0); PG8_SCHED; PG8_LDA(At, 0, 0); PG8_STAGE(PG8_SA(1, 1), a1 + hstepA, voffA);
            PG8_WAIT_L(8); PG8_BAR; PG8_WAIT_L(0); PG8_MMA(0, 0, At, B0); PG8_BAR; PG8_SCHED;
            PG8_LDB(B1, 0, 1); PG8_STAGE(PG8_SB(0, 0), b2, voffB);
            PG8_BAR; PG8_WAIT_L(0); PG8_MMA(0, 1, At, B1); PG8_BAR;
            PG8_LDA(At, 0, 1); PG8_STAGE(PG8_SA(0, 0), a2, voffA);
            PG8_BAR; PG8_WAIT_L(0); PG8_MMA(1, 0, At, B0); PG8_BAR; PG8_SCHED;
            PG8_STAGE(PG8_SB(0, 1), b2 + hstepB, voffB);
            PG8_WAIT_V(6); PG8_BAR; PG8_MMA(1, 1, At, B1); PG8_BAR;
            PG8_LDB(B0, 1, 0); PG8_SCHED; PG8_LDA(At, 1, 0); PG8_STAGE(PG8_SA(0, 1), a2 + hstepA, voffA);
            PG8_WAIT_L(8); PG8_BAR; PG8_WAIT_L(0); PG8_MMA(0, 0, At, B0); PG8_BAR; PG8_SCHED;
            PG8_LDB(B1, 1, 1); PG8_STAGE(PG8_SB(1, 0), b3, voffB);
            PG8_BAR; PG8_WAIT_L(0); PG8_MMA(0, 1, At, B1); PG8_BAR;
            PG8_LDA(At, 1, 1); PG8_STAGE(PG8_SA(1, 0), a3, voffA);
            PG8_BAR; PG8_WAIT_L(0); PG8_MMA(1, 0, At, B0); PG8_BAR; PG8_SCHED;
            PG8_STAGE(PG8_SB(1, 1), b3 + hstepB, voffB);
            PG8_WAIT_V(6); PG8_BAR; PG8_MMA(1, 1, At, B1); PG8_BAR;
            }
        }
        if constexpr (ALIGN_EPI) { if (wr == 0) PG8_BAR; }
        E(acc, cur, wr, wc, fr, fq);
        if (!has_next) break;
#pragma unroll
        for (int a = 0; a < 2; ++a)
#pragma unroll
            for (int b = 0; b < 2; ++b)
#pragma unroll
                for (int m = 0; m < 4; ++m)
#pragma unroll
                    for (int n = 0; n < 2; ++n) acc[a][b][m][n] = (f32x4){0.f, 0.f, 0.f, 0.f};
        cur = nxt; cA = nA; cB = nB; ++ui;
        if constexpr (ALIGN_EPI) { if (wr == 1) PG8_BAR; }
    }
    PG8_WAIT_V(0);
    if constexpr (!ALIGN_EPI) { if (wr == 0) PG8_BAR; }
    PG8_BAR;
#undef PG8_SA
#undef PG8_SB
#undef PG8_STAGE
#undef PG8_LDA
#undef PG8_LDB
#undef PG8_MMA
#undef PG8_WAIT_V
#undef PG8_WAIT_L
#undef PG8_BAR
#undef PG8_SCHED
#undef PG8_APTR
#undef PG8_BPTR
}
}

struct FStoreBf16 { bf16_t* O; int ld; float scale; int act; const float* ss;
    __device__ __forceinline__ float rowscale(int row) const { return ss ? scale * rsqrtf(ss[row] * (1.f / D) + EPS) : scale; }
    __device__ __forceinline__ void operator()(int row, int col, f32x4 v) const {
        if (act == 1) {
#pragma unroll
            for (int e = 0; e < 4; ++e) { const float r = fmaxf(v[e], 0.f); v[e] = r * r; }
        }
        u32x2 w; w.x = pk2(v[0], v[1]); w.y = pk2(v[2], v[3]); *(u32x2*)(O + (size_t)row * ld + col) = w; }
    __device__ __forceinline__ void f8(int row, int col, f32x4 a, f32x4 b) const {
        if (act == 1) {
#pragma unroll
            for (int e = 0; e < 4; ++e) { const float r = fmaxf(a[e], 0.f); a[e] = r * r; const float s = fmaxf(b[e], 0.f); b[e] = s * s; }
        }
        u32x4 w; w.x = pk2(a[0], a[1]); w.y = pk2(a[2], a[3]); w.z = pk2(b[0], b[1]); w.w = pk2(b[2], b[3]); *(u32x4*)(O + (size_t)row * ld + col) = w; } };
struct FResF32 { const float* base; int brow0; float* out; int ld;
    __device__ __forceinline__ float rowscale(int) const { return 1.f; }
    __device__ __forceinline__ void operator()(int row, int col, f32x4 v) const {
        const f32x4 b = *(const f32x4*)(base + (size_t)(row - brow0) * ld + col); *(f32x4*)(out + (size_t)row * ld + col) = b + v; } };
struct FZ { bf16_t* Zp; float* Gp;
    __device__ __forceinline__ float rowscale(int) const { return 1.f; }
    __device__ __forceinline__ void operator()(int row, int col, f32x4 v) const {
        if (row >= MT) return;
        if (col < NZ) { u32x2 w; w.x = pk2(v[0], v[1]); w.y = pk2(v[2], v[3]); *(u32x2*)(Zp + (size_t)row * NZ + col) = w; }
        else if (col < NZ + 8) *(f32x4*)(Gp + (size_t)row * 8 + (col - NZ)) = v; }
    __device__ __forceinline__ void f8(int row, int col, f32x4 a, f32x4 b) const {
        if (row >= MT) return;
        if (col < NZ) { u32x4 w; w.x = pk2(a[0], a[1]); w.y = pk2(a[2], a[3]); w.z = pk2(b[0], b[1]); w.w = pk2(b[2], b[3]); *(u32x4*)(Zp + (size_t)row * NZ + col) = w; }
        else if (col == NZ) { *(f32x4*)(Gp + (size_t)row * 8) = a; *(f32x4*)(Gp + (size_t)row * 8 + 4) = b; } } };
__device__ __forceinline__ f32x4 ld4_res(const float* p) { return __builtin_nontemporal_load((const f32x4*)p); }
__device__ __forceinline__ f32x4 ld4_res(const bf16_t* p) { const u32x2 w = *(const u32x2*)p; return (f32x4){bflo(w.x), bfhi(w.x), bflo(w.y), bfhi(w.y)}; }
template <class BT> struct FResNorm { const BT* base; int brow0; bf16_t* out; bf16_t* xn; const float* g; float* ssq;
    __device__ __forceinline__ float rowscale(int) const { return 1.f; }
    __device__ __forceinline__ void operator()(int row, int col, f32x4 v) const {
        const f32x4 x = ld4_res(base + (size_t)(row - brow0) * D + col) + v;
        u32x2 o; o.x = pk2(x[0], x[1]); o.y = pk2(x[2], x[3]); *(u32x2*)(out + (size_t)row * D + col) = o;
        const f32x4 gg = *(const f32x4*)(g + col); u32x2 w; w.x = pk2(x[0] * gg[0], x[1] * gg[1]); w.y = pk2(x[2] * gg[2], x[3] * gg[3]); *(u32x2*)(xn + (size_t)row * D + col) = w;
        atomicAdd(ssq + row, (x[0] * x[0] + x[1] * x[1]) + (x[2] * x[2] + x[3] * x[3])); } };
template <class BT> struct EpiResNorm { static constexpr bool PERM = true; const BT* base; bf16_t* out; bf16_t* xn; const float* g; float* ssq;
    __device__ __forceinline__ void operator()(const f32x4 (&acc)[2][2][4][2], const pg8::Unit& u, int wr, int wc, int fr, int fq) const {
        f32x4 gg[2][2];
#pragma unroll
        for (int bj = 0; bj < 2; ++bj) { const int col = u.pn * 256 + bj * 128 + wc * 32 + 8 * fq; gg[bj][0] = *(const f32x4*)(g + col); gg[bj][1] = *(const f32x4*)(g + col + 4); }
#pragma unroll
        for (int ai = 0; ai < 2; ++ai)
#pragma unroll
            for (int m = 0; m < 4; ++m) {
                const int row = u.pm * 256 + ai * 128 + wr * 64 + m * 16 + fr; float ss = 0.f;
#pragma unroll
                for (int bj = 0; bj < 2; ++bj) { const size_t o = (size_t)row * D + u.pn * 256 + bj * 128 + wc * 32 + 8 * fq;
                    const f32x4 x0 = ld4_res(base + o) + acc[ai][bj][m][0], x1 = ld4_res(base + o + 4) + acc[ai][bj][m][1];
                    u32x4 w; w.x = pk2(x0[0], x0[1]); w.y = pk2(x0[2], x0[3]); w.z = pk2(x1[0], x1[1]); w.w = pk2(x1[2], x1[3]); *(u32x4*)(out + o) = w;
                    const f32x4 y0 = x0 * gg[bj][0], y1 = x1 * gg[bj][1];
                    u32x4 z; z.x = pk2(y0[0], y0[1]); z.y = pk2(y0[2], y0[3]); z.z = pk2(y1[0], y1[1]); z.w = pk2(y1[2], y1[3]); *(u32x4*)(xn + o) = z;
                    ss += ((x0[0] * x0[0] + x0[1] * x0[1]) + (x0[2] * x0[2] + x0[3] * x0[3])) + ((x1[0] * x1[0] + x1[1] * x1[1]) + (x1[2] * x1[2] + x1[3] * x1[3])); }
                ss += __shfl_xor(ss, 16); ss += __shfl_xor(ss, 32);
                if (fq == 0) atomicAdd(ssq + row, ss);
                if (m & 1) asm volatile("" ::: "memory");
            }
    } };
struct FResB { const bf16_t* base; bf16_t* out;
    __device__ __forceinline__ float rowscale(int) const { return 1.f; }
    __device__ __forceinline__ void f8(int row, int col, f32x4 a, f32x4 b) const {
        const size_t o = (size_t)row * D + col; const f32x4 x0 = ld4_res(base + o) + a, x1 = ld4_res(base + o + 4) + b;
        u32x4 w; w.x = pk2(x0[0], x0[1]); w.y = pk2(x0[2], x0[3]); w.z = pk2(x1[0], x1[1]); w.w = pk2(x1[2], x1[3]); *(u32x4*)(out + o) = w; } };
struct EpiSoftmax { static constexpr bool PERM = true; bf16_t* P; LAS float* xch;
    __device__ __forceinline__ void operator()(f32x4 (&acc)[2][2][4][2], const pg8::Unit& u, int wr, int wc, int fr, int fq) const {
        float mx[2][4];
#pragma unroll
        for (int ai = 0; ai < 2; ++ai)
#pragma unroll
            for (int m = 0; m < 4; ++m) {
                float v = -INFINITY;
#pragma unroll
                for (int bj = 0; bj < 2; ++bj)
#pragma unroll
                    for (int n = 0; n < 2; ++n) v = fmaxf(v, fmaxf(fmaxf(acc[ai][bj][m][n][0], acc[ai][bj][m][n][1]), fmaxf(acc[ai][bj][m][n][2], acc[ai][bj][m][n][3])));
                v = fmaxf(v, __shfl_xor(v, 16)); v = fmaxf(v, __shfl_xor(v, 32));
                if (fq == 0) xch[(ai * 128 + wr * 64 + m * 16 + fr) * 4 + wc] = v;
            }
        asm volatile("s_waitcnt lgkmcnt(0)" ::: "memory"); __builtin_amdgcn_s_barrier(); asm volatile("" ::: "memory");
#pragma unroll
        for (int ai = 0; ai < 2; ++ai)
#pragma unroll
            for (int m = 0; m < 4; ++m) {
                const f32x4 t = *(const LAS f32x4*)(xch + (ai * 128 + wr * 64 + m * 16 + fr) * 4);
                mx[ai][m] = fmaxf(fmaxf(t[0], t[1]), fmaxf(t[2], t[3]));
                float s = 0.f;
#pragma unroll
                for (int bj = 0; bj < 2; ++bj)
#pragma unroll
                    for (int n = 0; n < 2; ++n)
#pragma unroll
                        for (int e = 0; e < 4; ++e) { const float p = __expf(acc[ai][bj][m][n][e] - mx[ai][m]); acc[ai][bj][m][n][e] = p; s += p; }
                s += __shfl_xor(s, 16); s += __shfl_xor(s, 32);
                if (fq == 0) xch[1024 + (ai * 128 + wr * 64 + m * 16 + fr) * 4 + wc] = s;
            }
        asm volatile("s_waitcnt lgkmcnt(0)" ::: "memory"); __builtin_amdgcn_s_barrier(); asm volatile("" ::: "memory");
#pragma unroll
        for (int ai = 0; ai < 2; ++ai)
#pragma unroll
            for (int m = 0; m < 4; ++m) {
                const f32x4 t = *(const LAS f32x4*)(xch + 1024 + (ai * 128 + wr * 64 + m * 16 + fr) * 4);
                const float inv = 1.f / ((t[0] + t[1]) + (t[2] + t[3]));
                const int row = u.pm * 256 + ai * 128 + wr * 64 + m * 16 + fr;
#pragma unroll
                for (int bj = 0; bj < 2; ++bj) { const f32x4 a = acc[ai][bj][m][0] * inv, b = acc[ai][bj][m][1] * inv;
                    u32x4 w; w.x = pk2(a[0], a[1]); w.y = pk2(a[2], a[3]); w.z = pk2(b[0], b[1]); w.w = pk2(b[2], b[3]);
                    *(u32x4*)(P + (size_t)row * 1024 + u.pn * 256 + bj * 128 + wc * 32 + 8 * fq) = w; }
            }
    } };
struct FVw { bf16_t* VWt;
    __device__ __forceinline__ float rowscale(int) const { return 1.f; }
    __device__ __forceinline__ void f8(int row, int col, f32x4 a, f32x4 b) const {
        const int bb = col >> 10, hk = col & 1023; u32x4 w; w.x = pk2(a[0], a[1]); w.y = pk2(a[2], a[3]); w.z = pk2(b[0], b[1]); w.w = pk2(b[2], b[3]);
        *(u32x4*)(VWt + ((size_t)bb * D + row) * 1024 + hk) = w; } };
struct FQkSplit { bf16_t* Qm; size_t kdelta;
    __device__ __forceinline__ float rowscale(int) const { return 1.f; }
    __device__ __forceinline__ void operator()(int row, int col, f32x4 v) const {
        const int h = col >> 9, j = col & 511; bf16_t* dst = Qm + (size_t)(j >> 8) * kdelta + (size_t)row * 1024 + h * 256 + (j & 255);
        u32x2 w; w.x = pk2(v[0], v[1]); w.y = pk2(v[2], v[3]); *(u32x2*)dst = w; }
    __device__ __forceinline__ void f8(int row, int col, f32x4 a, f32x4 b) const {
        const int h = col >> 9, j = col & 511; bf16_t* dst = Qm + (size_t)(j >> 8) * kdelta + (size_t)row * 1024 + h * 256 + (j & 255);
        u32x4 w; w.x = pk2(a[0], a[1]); w.y = pk2(a[2], a[3]); w.z = pk2(b[0], b[1]); w.w = pk2(b[2], b[3]); *(u32x4*)dst = w; } };
struct FMk { bf16_t* MK; float* out;
    __device__ __forceinline__ float rowscale(int) const { return 1.f; }
    __device__ __forceinline__ void operator()(int row, int col, f32x4 v) const {
        u32x2 w; w.x = pk2(v[0], v[1]); w.y = pk2(v[2], v[3]); *(u32x2*)(MK + (size_t)row * D + col) = w; __builtin_nontemporal_store(v, (f32x4*)(out + (size_t)row * D + col)); } };
struct FMvt { bf16_t* MVt; float* out;
    __device__ __forceinline__ float rowscale(int) const { return 1.f; }
    __device__ __forceinline__ void operator()(int row, int col, f32x4 v) const {
        u32x2 w; w.x = pk2(v[0], v[1]); w.y = pk2(v[2], v[3]); *(u32x2*)(MVt + ((size_t)(col >> 8) * D + row) * 256 + (col & 255)) = w;
#pragma unroll
        for (int e = 0; e < 4; ++e) out[(size_t)(col + e) * D + row] = v[e]; } };
struct FPart { float* P; int ld;
    __device__ __forceinline__ float rowscale(int) const { return 1.f; }
    __device__ __forceinline__ void operator()(int row, int col, f32x4 v) const { *(f32x4*)(P + (size_t)row * ld + col) = v; } };
struct FRi { bf16_t* R; size_t plane;
    __device__ __forceinline__ float rowscale(int) const { return 1.f; }
    __device__ __forceinline__ void operator()(int row, int col, f32x4 v) const {
        const int h = col >> 8, isI = (col >> 7) & 1, ch = h * 128 + (col & 127); u32x2 w; w.x = pk2(v[0], v[1]); w.y = pk2(v[2], v[3]); *(u32x2*)(R + (size_t)isI * plane + (size_t)row * 1024 + ch) = w; }
    __device__ __forceinline__ void f8(int row, int col, f32x4 a, f32x4 b) const {
        const int h = col >> 8, isI = (col >> 7) & 1, ch = h * 128 + (col & 127); u32x4 w; w.x = pk2(a[0], a[1]); w.y = pk2(a[2], a[3]); w.z = pk2(b[0], b[1]); w.w = pk2(b[2], b[3]);
        *(u32x4*)(R + (size_t)isI * plane + (size_t)row * 1024 + ch) = w; } };
__device__ __forceinline__ f32x2 gate_one(float rp, float ip, float ba, float bx, float sp, float xc) {
    const float r = sigmoidf_(rp + ba), i = sigmoidf_(ip + bx);
    const float la = -8.f * r * sp;
    const float a = __expf(la);
    return (f32x2){a, sqrtf(fmaxf(1.f - a * a, 0.f)) * (i * xc)};
}
template <class G>
__device__ __forceinline__ void skinny_piece(const bf16_t* A, int lda, const bf16_t* Bt, int ldb, int Kc, int ncol0, int row0, const G& g, const int w, LAS float* red) {
    const int lane = lane_id(), fr = lane & 15, fq = lane >> 4;
    const int kw = Kc >> 3, wk = (w + (int)blockIdx.x) & 7;
    f32x4 acc[8][2];
#pragma unroll
    for (int r = 0; r < 8; ++r) { acc[r][0] = (f32x4){0.f, 0.f, 0.f, 0.f}; acc[r][1] = (f32x4){0.f, 0.f, 0.f, 0.f}; }
    const bf16_t* ap = A + (size_t)fr * lda + wk * kw + 8 * fq;
    const bf16_t* bp = Bt + (size_t)(ncol0 + fr) * ldb + wk * kw + 8 * fq;
#pragma unroll 4
    for (int k = 0; k < kw; k += 32) {
        const bf16x8 b0 = ld8(bp + k), b1 = ld8(bp + (size_t)16 * ldb + k);
#pragma unroll
        for (int r = 0; r < 8; ++r) { const bf16x8 a = ld8(ap + (size_t)(16 * r) * lda + k); acc[r][0] = MFMA16(b0, a, acc[r][0]); acc[r][1] = MFMA16(b1, a, acc[r][1]); }
    }
    __syncthreads();
#pragma unroll
    for (int r = 0; r < 8; ++r)
#pragma unroll
        for (int t = 0; t < 2; ++t) *(LAS f32x4*)(red + ((w * 16 + r * 2 + t) * 64 + lane) * 4) = acc[r][t];
    __syncthreads();
#pragma unroll
    for (int t = 0; t < 2; ++t) {
        f32x4 s = (f32x4){0.f, 0.f, 0.f, 0.f};
#pragma unroll
        for (int ww = 0; ww < 8; ++ww) s = s + *(const LAS f32x4*)(red + ((ww * 16 + w * 2 + t) * 64 + lane) * 4);
        g(row0 + 16 * w + fr, ncol0 + 16 * t + 4 * fq, s * g.rowscale(row0 + 16 * w + fr));
    }
}
template <class G>
__device__ __forceinline__ void skinny_gemm(const bf16_t* A, int lda, const bf16_t* Bt, int ldb, int K, int N, int ksplit, int cu0, int ncu, int row0, const G& g, int part_rows, const int w, LAS float* red) {
    const int me = (int)blockIdx.x - cu0; if (me < 0 || me >= ncu) return;
    const int nsl = N / 32, np = nsl * ksplit, Kc = K / ksplit;
    for (int p = me; p < np; p += ncu) {
        const int sl = p % nsl, ks = p / nsl;
        skinny_piece(A + (size_t)ks * Kc, lda, Bt + (size_t)ks * Kc, ldb, Kc, 32 * sl, row0 + ks * part_rows, g, w, red);
    }
}
#define XB_TMO      128
#define XB_XCNT(j)  (256  + 64 * (j))
#define XB_XSUB(j)  (1280 + 64 * (j))
#define XB_XGEN(j)  (2304 + 64 * (j))
#define XB_TOP      3328
#define XB_TOPGEN   3392
#define XCD_BAR_WORDS 3456
#define XB_SPIN_CAP (1u << 18)
__device__ __forceinline__ unsigned xb_ld(unsigned* p)              { return __hip_atomic_load(p, __ATOMIC_RELAXED, __HIP_MEMORY_SCOPE_AGENT); }
__device__ __forceinline__ unsigned xb_add(unsigned* p, unsigned v) { return __hip_atomic_fetch_add(p, v, __ATOMIC_RELAXED, __HIP_MEMORY_SCOPE_AGENT); }
__device__ __forceinline__ unsigned xb_xcc_id() { return (unsigned)__builtin_amdgcn_s_getreg((3 << 11) | 20) & 0xFu; }
#define XB_SPIN(cond, bar) do { unsigned _sp = 0; while (cond) { __builtin_amdgcn_s_sleep(1); \
    if ((++_sp & 255u) == 0u) { if (xb_ld(&(bar)[XB_TMO])) break; if (_sp > XB_SPIN_CAP) { atomicAdd(&(bar)[XB_TMO], 1u); break; } } } } while (0)
struct XcdBarrier { unsigned* bar; unsigned x; volatile LAS unsigned* st; };
__device__ __forceinline__ void xcd_barrier_complete(unsigned* bar, unsigned x, unsigned& nloc, unsigned& nx) {
    const unsigned G = gridDim.x * gridDim.y * gridDim.z;
    unsigned sum, cnt, mine, sp = 0u;
    for (;;) {
        sum = 0u; cnt = 0u; mine = 0u;
#pragma unroll
        for (unsigned j = 0; j < 16; ++j) { const unsigned c = xb_ld(&bar[XB_XCNT(j)]); sum += c; cnt += (c > 0u) ? 1u : 0u; mine = (j == x) ? c : mine; }
        if (sum == G) break;
        __builtin_amdgcn_s_sleep(1);
        if ((++sp & 255u) == 0u) { if (xb_ld(&bar[XB_TMO])) break; if (sp > XB_SPIN_CAP) { atomicAdd(&bar[XB_TMO], 1u); break; } }
    }
    nloc = mine > 0u ? mine : 1u; nx = cnt > 0u ? cnt : 1u;
}
__device__ __forceinline__ void xcd_barrier(const XcdBarrier& b, const int wave) {
    asm volatile("s_waitcnt vmcnt(0)" ::: "memory");
    __syncthreads();
    if (wave == 0 && lane_id() == 0) {
        unsigned* bar = b.bar;
        __builtin_amdgcn_s_waitcnt(0);
        unsigned nloc = b.st[0], nx = b.st[1];
        if (nloc == 0u) { xcd_barrier_complete(bar, b.x, nloc, nx); b.st[0] = nloc; b.st[1] = nx; }
        const unsigned old = xb_add(&bar[XB_XSUB(b.x)], 1u);
        const unsigned gen = old / nloc;
        if (old + 1u == (gen + 1u) * nloc) {
            __builtin_amdgcn_fence(__ATOMIC_RELEASE, "agent");
            asm volatile("s_waitcnt vmcnt(0)" ::: "memory");
            const unsigned og = xb_add(&bar[XB_TOP], 1u);
            const unsigned tg = og / nx;
            if (og + 1u == (tg + 1u) * nx) xb_add(&bar[XB_TOPGEN], 1u);
            else XB_SPIN(xb_ld(&bar[XB_TOPGEN]) == tg, bar);
            __builtin_amdgcn_fence(__ATOMIC_ACQUIRE, "agent");
            xb_add(&bar[XB_XGEN(b.x)], 1u);
            asm volatile("s_waitcnt vmcnt(0)" ::: "memory");
        } else {
            XB_SPIN(xb_ld(&bar[XB_XGEN(b.x)]) == gen, bar);
            __builtin_amdgcn_fence(__ATOMIC_ACQUIRE, "agent");
            asm volatile("s_waitcnt vmcnt(0)" ::: "memory");
        }
    }
    __syncthreads();
}

struct Args { const float* in[39]; float* out; unsigned char* ws; int ph_lo, ph_hi; };
enum { I_XP = 0, I_XS, I_MEM, I_SRH, I_SRC, I_SMC_, I_SMN, I_SMM, I_SMCV, I_CK, I_CV, I_GMIX, I_WIN, I_CRW, I_CRB, I_WA, I_BA, I_WX, I_BX, I_LAM, I_GRNN,
       I_CMW, I_CMB, I_WQ, I_WK, I_BI, I_BF, I_GML, I_WOUT, I_GX, I_GMEM, I_WCQ, I_WMK, I_WMV, I_WCO, I_GFFN, I_WUP, I_WDN, I_GFIN };

__device__ __forceinline__ void transpose_item(const float* W, int ldw, bf16_t* WT, int ldt, LAS float* scr, int kb, int nb, int lane) {
    const int k0 = 64 * kb, n0 = 32 * nb;
    f32x4 ld[8];
#pragma unroll
    for (int i = 0; i < 8; ++i) ld[i] = __builtin_nontemporal_load((const f32x4*)(W + (size_t)(k0 + 8 * i + (lane >> 3)) * ldw + n0 + 4 * (lane & 7)));
#pragma unroll
    for (int i = 0; i < 8; ++i) { LAS float* d = scr + (8 * i + (lane >> 3)) * 33 + 4 * (lane & 7); d[0] = ld[i][0]; d[1] = ld[i][1]; d[2] = ld[i][2]; d[3] = ld[i][3]; }
    asm volatile("s_waitcnt lgkmcnt(0)" ::: "memory");
    const int c = lane & 7;
#pragma unroll
    for (int j = 0; j < 4; ++j) { const int n = (lane >> 3) + 8 * j; const LAS float* s = scr + (8 * c) * 33 + n;
        u32x4 o; o.x = pk2(s[0 * 33], s[1 * 33]); o.y = pk2(s[2 * 33], s[3 * 33]); o.z = pk2(s[4 * 33], s[5 * 33]); o.w = pk2(s[6 * 33], s[7 * 33]);
        *(u32x4*)(WT + (size_t)(n0 + n) * ldt + k0 + 8 * c) = o; }
    asm volatile("s_waitcnt lgkmcnt(0)" ::: "memory");
}
__device__ __forceinline__ void convert_matrix(const float* W, int ldw, int K, int N, bf16_t* WT, int ldt, LAS float* scr, int gw_, int ngw_, int lane) {
    const int nb = N / 32, items = (K / 64) * nb;
    for (int it = gw_; it < items; it += ngw_) transpose_item(W, ldw, WT, ldt, scr, it / nb, it % nb, lane);
}
__device__ __forceinline__ void load_gain(const float* g, int lane, f32x4 (&gg)[8]) {
#pragma unroll
    for (int j = 0; j < 8; ++j) gg[j] = *(const f32x4*)(g + 256 * j + 4 * lane);
}
__device__ __forceinline__ void norm_row(const float* xrow, const f32x4 (&gg)[8], bf16_t* orow, int lane) {
    f32x4 v[8]; float ss = 0.f;
#pragma unroll
    for (int j = 0; j < 8; ++j) { v[j] = __builtin_nontemporal_load((const f32x4*)(xrow + 256 * j + 4 * lane)); ss += (v[j][0] * v[j][0] + v[j][1] * v[j][1]) + (v[j][2] * v[j][2] + v[j][3] * v[j][3]); }
    const float rstd = rsqrtf(wave_sum(ss) * (1.f / D) + EPS);
#pragma unroll
    for (int j = 0; j < 8; ++j) { const f32x4 a = v[j] * rstd * gg[j]; u32x2 w; w.x = pk2(a[0], a[1]); w.y = pk2(a[2], a[3]); *(u32x2*)(orow + 256 * j + 4 * lane) = w; }
}

#define wsWinT ((bf16_t*)(ws + WS_WIN2))
#define wsWoutT ((bf16_t*)(ws + WS_WOUT))
#define wsWcqT ((bf16_t*)(ws + WS_WCQ))
#define wsWmkT ((bf16_t*)(ws + WS_WMK))
#define wsWmvT ((bf16_t*)(ws + WS_WMV))
#define wsWcoT ((bf16_t*)(ws + WS_WCO))
#define wsWupT ((bf16_t*)(ws + WS_WUP))
#define wsWdnT ((bf16_t*)(ws + WS_WDN))
#define wsWgT ((bf16_t*)(ws + WS_WG))
#define wsWqkT ((bf16_t*)(ws + WS_WQK))
#define wsXN ((bf16_t*)(ws + WS_XN))
#define wsMN ((bf16_t*)(ws + WS_MN))
#define wsZ ((bf16_t*)(ws + WS_Z))
#define wsGATES ((float*)(ws + WS_GATES))
#define wsXC ((bf16_t*)(ws + WS_XC))
#define wsUC ((bf16_t*)(ws + WS_UC))
#define wsAU ((bf16_t*)(ws + WS_AU))
#define wsQm ((bf16_t*)(ws + WS_QM))
#define wsKm ((bf16_t*)(ws + WS_KM))
#define wsY ((bf16_t*)(ws + WS_Y))
#define wsX1 ((bf16_t*)(ws + WS_X1))
#define wsX2 ((bf16_t*)(ws + WS_X2))
#define wsQC ((bf16_t*)(ws + WS_QC))
#define wsOC ((bf16_t*)(ws + WS_OC))
#define wsMK ((bf16_t*)(ws + WS_MK))
#define wsMVt ((bf16_t*)(ws + WS_MVT))
#define wsVW ((bf16_t*)(ws + WS_Y))
#define wsU ((bf16_t*)(ws + WS_U))
#define wsCLOC ((bf16_t*)(ws + WS_CLOC))
#define wsCIN ((bf16_t*)(ws + WS_CIN))
#define wsNLOC ((float*)(ws + WS_NLOC))
#define wsNIN ((float*)(ws + WS_NIN))
#define wsMSTAT ((float*)(ws + WS_MSTAT))
#define wsMINB (wsMSTAT + 1024)
#define wsSUM ((float*)(ws + WS_SUM))
#define wsPART ((float*)(ws + WS_PART))
#define wsSPL (wsMSTAT + 4096)
#define wsSS (wsMSTAT + 8192)
#define wsPB ((bf16_t*)(ws + WS_U))
__global__ void __launch_bounds__(512, 2) mega_fwd(Args args) {
    extern __shared__ __attribute__((aligned(16))) unsigned char lds_raw[];
    LAS unsigned char* lds = (LAS unsigned char*)lds_raw;
    LAS float* misc = (LAS float*)(lds + MISC_OFF);
    const int wave = __builtin_amdgcn_readfirstlane((int)threadIdx.x >> 6);
    const int G = gridDim.x, bid = blockIdx.x;
    const int NGW = G * 8, NGT = G * 512;
#define PH_IDS const int lane = lane_id(); const int tid = wave * 64 + lane; const int gw = bid * 8 + wave; const int gt = bid * 512 + tid; (void)gw; (void)gt; (void)lane; (void)tid;
    unsigned char* ws = args.ws;
    float* out = args.out;
    volatile LAS unsigned* bst = (volatile LAS unsigned*)(lds + LDS_BYTES - 16);
    if (wave == 0 && lane_id() == 0) { bst[0] = 0u; bst[1] = 0u; }
    __syncthreads();
    XcdBarrier xbar; xbar.bar = (unsigned*)(ws + WS_CTL); xbar.x = xb_xcc_id(); xbar.st = bst;
    if (wave == 0 && lane_id() == 0) (void)xb_add(&xbar.bar[XB_XCNT(xbar.x)], 1u);
    const int lo = args.ph_lo, hi = args.ph_hi;
#ifndef PH_MASK
#define PH_MASK 0xFFFF
#endif
#define IN(k) (((PH_MASK >> (k)) & 1) && lo <= (k) && (k) < hi)
#ifndef DUP_MASK
#define DUP_MASK 0
#endif
#define REP(k) for (int rep_ = 0; rep_ <= ((DUP_MASK >> (k)) & 1); ++rep_)
#ifndef DUP_BAR
#define DUP_BAR 0
#endif
#define SEAM(k) do { if (IN(k)) { xcd_barrier(xbar, wave); if (DUP_BAR) { xcd_barrier(xbar, wave); xcd_barrier(xbar, wave); } } } while (0)

    REP(0) if (IN(0)) { PH_IDS
        LAS float* scr = (LAS float*)(lds + wave * 16384);
        constexpr int I_A = 32 * 160, I_S = 32 * 64, NIT = I_A + 3 * I_S;
        for (int it = gw; it < NIT; it += NGW) {
            int r = it;
            if (r < I_A) { transpose_item(args.in[I_WIN], DIN, wsWinT, D, scr, r / 160, r % 160, lane); continue; } r -= I_A;
            if (r < I_S) { transpose_item(args.in[I_WOUT], D, wsWoutT, D, scr, r / 64, r % 64, lane); continue; } r -= I_S;
            if (r < I_S) { transpose_item(args.in[I_WMK], D, wsWmkT, D, scr, r / 64, r % 64, lane); continue; } r -= I_S;
            transpose_item(args.in[I_WMV], D, wsWmvT, D, scr, r / 64, r % 64, lane);
        }
        for (int idx = gt; idx < 8 * 256 * 256; idx += NGT) {
            const int h = idx >> 16, j = (idx >> 8) & 255, k = idx & 255, kk = k - (h & 1) * 128;
            float v = 0.f;
            if (kk >= 0 && kk < 128) v = (j < 128) ? args.in[I_WA][((size_t)h * 128 + kk) * 128 + j] : args.in[I_WX][((size_t)h * 128 + kk) * 128 + (j - 128)];
            wsWgT[idx] = (bf16_t)f2bf(v);
        }
        for (int idx = gt; idx < 4 * 512 * 256; idx += NGT) {
            const int h = idx >> 17, j = (idx >> 8) & 511, k = idx & 255;
            const float v = (j < 256) ? args.in[I_WQ][((size_t)h * 256 + k) * 256 + j] : args.in[I_WK][((size_t)h * 256 + k) * 256 + (j - 256)] * 0.0625f;
            wsWqkT[idx] = (bf16_t)f2bf(v);
        }
        for (int idx = gt; idx < 2 * MT; idx += NGT) wsSS[idx] = 0.f;
        for (int idx = gt; idx < 1024; idx += NGT) { const float l = args.in[I_LAM][idx]; wsSPL[idx] = fmaxf(-l, 0.f) + log1pf(__expf(-fabsf(l))); }
        for (int idx = gt; idx < 8 * 2048; idx += NGT) { const int c = idx >> 11, k = idx & 2047; wsWinT[(size_t)(NZ + c) * D + k] = (bf16_t)f2bf(args.in[I_WIN][(size_t)k * DIN + NZ + c]); }
        { f32x4 gg[8]; load_gain(args.in[I_GMIX], lane, gg);
          for (int m = gw; m < MT; m += NGW) { const float* xrow = m < MP ? args.in[I_XP] + (size_t)m * D : args.in[I_XS] + (size_t)(m - MP) * D; norm_row(xrow, gg, wsXN + (size_t)m * D, lane); } }
        { f32x4 gg[8]; load_gain(args.in[I_GMEM], lane, gg);
          for (int m = gw; m < MMEM; m += NGW) norm_row(args.in[I_MEM] + (size_t)m * D, gg, wsMN + (size_t)m * D, lane); }
        __syncthreads();
    }
    SEAM(0);

    REP(1) if (IN(1)) { PH_IDS
        { const pg8::Gemm g = pg8::mk_gemm(wsXN, wsWinT, D * 2, D * 2, D, 0); pg8::StaticOrder S; S.init(33, 21, G, bid);
          pg8::EpiF8<FZ> E{{wsZ, wsGATES}}; pg8::gemm_phase<pg8::EpiF8<FZ>, true, true>(lds, g, S, E, wave); }
        { const pg8::Gemm g = pg8::mk_gemm(wsMN, wsWmkT, D * 2, D * 2, D, 0); pg8::StaticOrder S; S.init(4, 8, G, G - 1 - bid);
          pg8::EpiF<FMk> E{{wsMK, out + O_PK}}; pg8::gemm_phase<pg8::EpiF<FMk>, true, true>(lds, g, S, E, wave); }
        { const pg8::Gemm g = pg8::mk_gemm(wsMN, wsWmvT, D * 2, D * 2, D, 0); pg8::StaticOrder S; S.init(4, 8, G, G - 33 - bid);
          pg8::EpiF<FMk> E{{wsMVt, out + O_PV}}; pg8::gemm_phase<pg8::EpiF<FMk>, true, true>(lds, g, S, E, wave); }
    }
    SEAM(1);

    REP(2) if (IN(2)) { PH_IDS
        const int gi = gt & 255, which = gi >> 7, c0 = (gi & 127) * 8, zc = (which ? OFF_MU : OFF_RX) + c0;
        const float* cw = args.in[which ? I_CMW : I_CRW]; const float* cb = args.in[which ? I_CMB : I_CRB];
        float wt[4][8], wb[8];
#pragma unroll
        for (int e = 0; e < 8; ++e) { wb[e] = cb[c0 + e];
#pragma unroll
            for (int j = 0; j < 4; ++j) wt[j][e] = cw[j * 1024 + c0 + e]; }
        for (int m = gt >> 8; m < MT; m += NGT >> 8) {
            float x[4][8];
            if (m < MP) {
                const int t = m & (TT - 1);
#pragma unroll
                for (int j = 0; j < 4; ++j) {
                    if (t - 3 + j >= 0) { const u32x4 w = *(const u32x4*)(wsZ + (size_t)(m - 3 + j) * NZ + zc);
                        x[j][0] = bflo(w.x); x[j][1] = bfhi(w.x); x[j][2] = bflo(w.y); x[j][3] = bfhi(w.y); x[j][4] = bflo(w.z); x[j][5] = bfhi(w.z); x[j][6] = bflo(w.w); x[j][7] = bfhi(w.w); }
                    else {
#pragma unroll
                        for (int e = 0; e < 8; ++e) x[j][e] = 0.f; }
                }
                if (t >= TT - 3) { float* o = out + (which ? O_PMC : O_PRC) + ((size_t)(m >> 11) * 3 + (t - (TT - 3))) * 1024 + c0;
                    *(f32x4*)o = (f32x4){x[3][0], x[3][1], x[3][2], x[3][3]}; *(f32x4*)(o + 4) = (f32x4){x[3][4], x[3][5], x[3][6], x[3][7]}; }
            } else {
                const int sb = m - MP; const float* st = args.in[which ? I_SMCV : I_SRC] + (size_t)sb * 3 * 1024 + c0;
#pragma unroll
                for (int j = 0; j < 3; ++j) { const f32x4 a = *(const f32x4*)(st + j * 1024), b = *(const f32x4*)(st + j * 1024 + 4);
                    x[j][0] = a[0]; x[j][1] = a[1]; x[j][2] = a[2]; x[j][3] = a[3]; x[j][4] = b[0]; x[j][5] = b[1]; x[j][6] = b[2]; x[j][7] = b[3]; }
                const u32x4 w = *(const u32x4*)(wsZ + (size_t)m * NZ + zc);
                x[3][0] = bflo(w.x); x[3][1] = bfhi(w.x); x[3][2] = bflo(w.y); x[3][3] = bfhi(w.y); x[3][4] = bflo(w.z); x[3][5] = bfhi(w.z); x[3][6] = bflo(w.w); x[3][7] = bfhi(w.w);
                float* o = out + (which ? O_SMC : O_SRC) + (size_t)sb * 3 * 1024 + c0;
#pragma unroll
                for (int j = 0; j < 3; ++j) { *(f32x4*)(o + j * 1024) = (f32x4){x[j + 1][0], x[j + 1][1], x[j + 1][2], x[j + 1][3]}; *(f32x4*)(o + j * 1024 + 4) = (f32x4){x[j + 1][4], x[j + 1][5], x[j + 1][6], x[j + 1][7]}; }
            }
            float y[8];
#pragma unroll
            for (int e = 0; e < 8; ++e) y[e] = wb[e];
#pragma unroll
            for (int j = 0; j < 4; ++j)
#pragma unroll
                for (int e = 0; e < 8; ++e) y[e] += wt[j][e] * x[j][e];
            if (which) {
#pragma unroll
                for (int e = 0; e < 8; ++e) y[e] = y[e] * sigmoidf_(y[e]);
            }
            u32x4 w; w.x = pk2(y[0], y[1]); w.y = pk2(y[2], y[3]); w.z = pk2(y[4], y[5]); w.w = pk2(y[6], y[7]);
            *(u32x4*)((which ? wsUC : wsXC) + (size_t)m * 1024 + c0) = w;
        }
    }
    SEAM(2);

    REP(3) if (IN(3)) { PH_IDS
        { const pg8::Gemm g = pg8::mk_gemm(wsXC, wsWgT, 2048, 512, 256, 512); pg8::StaticOrder S; S.init(32, 8, G, bid);
          pg8::EpiF8<FRi> E{{wsAU, (size_t)MT * 1024}}; pg8::gemm_phase<pg8::EpiF8<FRi>, true, true>(lds, g, S, E, wave); }
        { const pg8::Gemm g = pg8::mk_gemm(wsUC, wsWqkT, 2048, 512, 256, 512); pg8::StaticOrder S; S.init(32, 8, G, bid);
          pg8::EpiF8<FQkSplit> E{{wsQm, (WS_KM - WS_QM) / 2}}; pg8::gemm_phase<pg8::EpiF8<FQkSplit>, true, true>(lds, g, S, E, wave); }
        if (bid < 64) { const int h = bid >> 3;
            skinny_piece(wsXC + (size_t)MP * 1024 + 256 * (h >> 1), 1024, wsWgT, 256, 256, 32 * bid, MP, FRi{wsAU, (size_t)MT * 1024}, wave, (LAS float*)lds); }
        else if (bid < 128) { const int p = bid - 64; const int hh = p >> 4;
            skinny_piece(wsUC + (size_t)MP * 1024 + 256 * hh, 1024, wsWqkT, 256, 256, 32 * p, MP, FQkSplit{wsQm, (WS_KM - WS_QM) / 2}, wave, (LAS float*)lds); }
    }
    SEAM(3);

    REP(4) if (IN(4)) { PH_IDS
        for (int u = bid; u < 256; u += G) {
            const int m0 = (u >> 6) * TT + (u & 63) * 32;
            float A0 = 1.f, A1 = 1.f, h0 = 0.f, h1 = 0.f;
            const f32x2 ba = *(const f32x2*)(args.in[I_BA] + 2 * tid), bx = *(const f32x2*)(args.in[I_BX] + 2 * tid), sp = *(const f32x2*)(wsSPL + 2 * tid);
#pragma unroll 8
            for (int i = 0; i < 32; ++i) { const size_t o = (size_t)(m0 + i) * 1024 + 2 * tid;
                const unsigned rw_ = *(const unsigned*)(wsAU + o), iw_ = *(const unsigned*)(wsAU + (size_t)MT * 1024 + o); const f32x2 rp = (f32x2){bflo(rw_), bfhi(rw_)}, ip = (f32x2){bflo(iw_), bfhi(iw_)}; const unsigned xw = *(const unsigned*)(wsXC + o);
                const f32x2 g0 = gate_one(rp[0], ip[0], ba[0], bx[0], sp[0], bflo(xw)), g1 = gate_one(rp[1], ip[1], ba[1], bx[1], sp[1], bfhi(xw));
                h0 = g0[0] * h0 + g0[1]; A0 *= g0[0]; h1 = g1[0] * h1 + g1[1]; A1 *= g1[0]; }
            *(f32x4*)(wsSUM + ((size_t)u * 1024 + 2 * tid) * 2) = (f32x4){A0, h0, A1, h1};
        }
        for (int u = bid; u < 256; u += G) {
            const int bh = u >> 4, c = u & 15, b = bh >> 2, h = bh & 3, m0 = b * TT + c * 128;
            LAS float* ic = misc; LAS float* bb = misc + 128; LAS float* wv = misc + 256; LAS float* sc = misc + 384;
            __syncthreads();
            if (tid < 128) { ic[tid] = wsGATES[(size_t)(m0 + tid) * 8 + h] + args.in[I_BI][h]; bb[tid] = logsigmoid_(wsGATES[(size_t)(m0 + tid) * 8 + 4 + h] + args.in[I_BF][h]); }
            __syncthreads();
            if (wave == 0) {
                const float x0 = bb[2 * lane], x1 = bb[2 * lane + 1], loc = x0 + x1; float inc = loc;
#pragma unroll
                for (int o = 1; o < 64; o <<= 1) { const float t = __shfl_up(inc, o); if (lane >= o) inc += t; }
                const float b0 = inc - x1, b1 = inc, a = __shfl(inc, 63);
                const float mx = wave_max(fmaxf(ic[2 * lane] + a - b0, ic[2 * lane + 1] + a - b1));
                bb[2 * lane] = b0; bb[2 * lane + 1] = b1;
                if (lane == 0) { sc[0] = mx; sc[1] = a; wsMSTAT[u * 2] = mx; wsMSTAT[u * 2 + 1] = a; }
            }
            __syncthreads();
            if (tid < 128) wv[tid] = __expf(ic[tid] + sc[1] - bb[tid] - sc[0]);
            __syncthreads();
            LAS unsigned char* VTl = lds; LAS unsigned char* KTl = lds + 67584;
            for (int idx = tid; idx < 128 * 32; idx += 512) {
                const int s = idx >> 5, ch = idx & 31; const float w = wv[s];
                const u32x4 v = *(const u32x4*)(wsZ + (size_t)(m0 + s) * NZ + OFF_MV + h * 256 + ch * 8);
                u32x4 o; o.x = pk2(bflo(v.x) * w, bfhi(v.x) * w); o.y = pk2(bflo(v.y) * w, bfhi(v.y) * w); o.z = pk2(bflo(v.z) * w, bfhi(v.z) * w); o.w = pk2(bflo(v.w) * w, bfhi(v.w) * w);
                *(LAS u32x4*)(VTl + s * 528 + ch * 16) = o;
                *(LAS u32x4*)(KTl + s * 528 + ch * 16) = *(const u32x4*)(wsKm + (size_t)(m0 + s) * 1024 + h * 256 + ch * 8);
            }
            __syncthreads();
            {
                const int g4 = lane >> 4, q = (lane & 15) >> 2, p = lane & 3;
                f32x4 acc[2][16];
#pragma unroll
                for (int a = 0; a < 2; ++a)
#pragma unroll
                    for (int k = 0; k < 16; ++k) acc[a][k] = (f32x4){0.f, 0.f, 0.f, 0.f};
                for (int ks = 0; ks < 4; ++ks) {
                    const int rb = (32 * ks + 8 * g4 + q) * 528 + 8 * p;
                    bf16x8 yv[2];
#pragma unroll
                    for (int a = 0; a < 2; ++a) yv[a] = cat8(tr_read(VTl + rb + (32 * wave + 16 * a) * 2), tr_read(VTl + rb + 4 * 528 + (32 * wave + 16 * a) * 2));
#pragma unroll
                    for (int kt = 0; kt < 16; ++kt) {
                        const bf16x8 xk = cat8(tr_read(KTl + rb + 32 * kt), tr_read(KTl + rb + 4 * 528 + 32 * kt));
                        acc[0][kt] = MFMA16(xk, yv[0], acc[0][kt]); acc[1][kt] = MFMA16(xk, yv[1], acc[1][kt]);
                    }
                }
#pragma unroll
                for (int a = 0; a < 2; ++a)
#pragma unroll
                    for (int kt = 0; kt < 16; ++kt) { u32x2 w; w.x = pk2(acc[a][kt][0], acc[a][kt][1]); w.y = pk2(acc[a][kt][2], acc[a][kt][3]);
                        *(u32x2*)(wsCLOC + (size_t)u * 65536 + (size_t)(32 * wave + 16 * a + (lane & 15)) * 256 + 16 * kt + 4 * g4) = w; }
            }
            if (tid < 256) { float s = 0.f; for (int i = 0; i < 128; ++i) s += wv[i] * bf2f(*(const LAS bf16_t*)(KTl + i * 528 + tid * 2)); wsNLOC[(size_t)u * 256 + tid] = s; }
            __syncthreads();
        }
    }
    SEAM(4);

    REP(5) if (IN(5)) { PH_IDS
        for (int st_ = 0; st_ < 3; ++st_) { const int which = (bid & 1) ? (st_ + 2) % 3 : st_;
        __syncthreads();
        if (which == 0) for (int u = bid; u < 288; u += G) {
            LAS float* tile = (LAS float*)lds;
            __syncthreads();
            if (u < 256) {
                const int b = u >> 6, ch = u & 63, m0 = b * TT + ch * 32;
                float h0 = 0.f, h1 = 0.f;
                const f32x2 ba = *(const f32x2*)(args.in[I_BA] + 2 * tid), bx = *(const f32x2*)(args.in[I_BX] + 2 * tid), sp = *(const f32x2*)(wsSPL + 2 * tid);
#pragma unroll 8
                for (int cc = 0; cc < ch; ++cc) { const f32x4 q = *(const f32x4*)(wsSUM + ((size_t)(b * 64 + cc) * 1024 + 2 * tid) * 2); h0 = q[0] * h0 + q[1]; h1 = q[2] * h1 + q[3]; }
#pragma unroll 8
                for (int i = 0; i < 32; ++i) {
                    const size_t o = (size_t)(m0 + i) * 1024 + 2 * tid;
                    const unsigned rw_ = *(const unsigned*)(wsAU + o), iw_ = *(const unsigned*)(wsAU + (size_t)MT * 1024 + o); const f32x2 rp = (f32x2){bflo(rw_), bfhi(rw_)}, ip = (f32x2){bflo(iw_), bfhi(iw_)}; const unsigned xw = *(const unsigned*)(wsXC + o);
                    const f32x2 g0 = gate_one(rp[0], ip[0], ba[0], bx[0], sp[0], bflo(xw)), g1 = gate_one(rp[1], ip[1], ba[1], bx[1], sp[1], bfhi(xw));
                    h0 = g0[0] * h0 + g0[1]; h1 = g1[0] * h1 + g1[1];
                    const unsigned gr = *(const unsigned*)(wsZ + (size_t)(m0 + i) * NZ + OFF_RG + 2 * tid);
                    *(LAS f32x2*)(tile + i * 1024 + 2 * tid) = (f32x2){h0 * gelu_tanh(bflo(gr)), h1 * gelu_tanh(bfhi(gr))};
                }
                if (ch == 63) *(f32x2*)(out + O_PH + (size_t)b * 1024 + 2 * tid) = (f32x2){h0, h1};
            } else {
                const int sb0 = (u - 256) * 4;
                const f32x2 ba = *(const f32x2*)(args.in[I_BA] + 2 * tid), bx = *(const f32x2*)(args.in[I_BX] + 2 * tid), sp = *(const f32x2*)(wsSPL + 2 * tid);
#pragma unroll
                for (int i = 0; i < 4; ++i) {
                    const int sb = sb0 + i, m = MP + sb;
                    const size_t o = (size_t)m * 1024 + 2 * tid;
                    const unsigned rw_ = *(const unsigned*)(wsAU + o), iw_ = *(const unsigned*)(wsAU + (size_t)MT * 1024 + o); const f32x2 rp = (f32x2){bflo(rw_), bfhi(rw_)}, ip = (f32x2){bflo(iw_), bfhi(iw_)}; const unsigned xw = *(const unsigned*)(wsXC + o);
                    const f32x2 g0 = gate_one(rp[0], ip[0], ba[0], bx[0], sp[0], bflo(xw)), g1 = gate_one(rp[1], ip[1], ba[1], bx[1], sp[1], bfhi(xw));
                    const f32x2 hp = *(const f32x2*)(args.in[I_SRH] + (size_t)sb * 1024 + 2 * tid);
                    const float h0 = g0[0] * hp[0] + g0[1], h1 = g1[0] * hp[1] + g1[1];
                    *(f32x2*)(out + O_SH + (size_t)sb * 1024 + 2 * tid) = (f32x2){h0, h1};
                    const unsigned gr = *(const unsigned*)(wsZ + (size_t)m * NZ + OFF_RG + 2 * tid);
                    *(LAS f32x2*)(tile + i * 1024 + 2 * tid) = (f32x2){h0 * gelu_tanh(bflo(gr)), h1 * gelu_tanh(bfhi(gr))};
                }
            }
            __syncthreads();
            const int mrow0 = (u < 256) ? ((u >> 6) * TT + (u & 63) * 32) : (MP + (u - 256) * 4);
            const int nrows = (u < 256) ? 32 : 4;
#pragma unroll
            for (int r = 0; r < 4; ++r) {
                const int i = wave * 4 + r; if (i >= nrows) continue; f32x4 v[4]; float ss = 0.f;
#pragma unroll
                for (int j = 0; j < 4; ++j) { v[j] = *(const LAS f32x4*)(tile + i * 1024 + 256 * j + 4 * lane); ss += (v[j][0] * v[j][0] + v[j][1] * v[j][1]) + (v[j][2] * v[j][2] + v[j][3] * v[j][3]); }
                const float rstd = rsqrtf(wave_sum(ss) * (1.f / 1024.f) + EPS);
#pragma unroll
                for (int j = 0; j < 4; ++j) { const f32x4 gg = *(const f32x4*)(args.in[I_GRNN] + 256 * j + 4 * lane); const f32x4 o = v[j] * rstd * gg;
                    u32x2 w; w.x = pk2(o[0], o[1]); w.y = pk2(o[2], o[3]); *(u32x2*)(wsY + (size_t)(mrow0 + i) * D + 256 * j + 4 * lane) = w; }
            }
        }
        if (which == 1) for (int u = bid; u < 256; u += G) {
            const int bh = u >> 4, sl = u & 15, v = 16 * sl + (tid >> 5), k0 = (tid & 31) * 8;
            float cs[8];
#pragma unroll
            for (int e = 0; e < 8; ++e) cs[e] = 0.f;
            float m = 0.f, ns = 0.f;
#pragma unroll
            for (int c = 0; c < 16; ++c) {
                const int cu = bh * 16 + c; const float mloc = wsMSTAT[cu * 2], bL = wsMSTAT[cu * 2 + 1];
                const float mn = fmaxf(bL + m, mloc), al = __expf(bL + m - mn), be = __expf(mloc - mn);
                u32x4 w; w.x = pk2(cs[0], cs[1]); w.y = pk2(cs[2], cs[3]); w.z = pk2(cs[4], cs[5]); w.w = pk2(cs[6], cs[7]);
                *(u32x4*)(wsCIN + (size_t)cu * 65536 + (size_t)v * 256 + k0) = w;
                const u32x4 l = *(const u32x4*)(wsCLOC + (size_t)cu * 65536 + (size_t)v * 256 + k0);
                cs[0] = al * cs[0] + be * bflo(l.x); cs[1] = al * cs[1] + be * bfhi(l.x); cs[2] = al * cs[2] + be * bflo(l.y); cs[3] = al * cs[3] + be * bfhi(l.y);
                cs[4] = al * cs[4] + be * bflo(l.z); cs[5] = al * cs[5] + be * bfhi(l.z); cs[6] = al * cs[6] + be * bflo(l.w); cs[7] = al * cs[7] + be * bfhi(l.w);
                if (sl == 0 && tid < 256) { wsNIN[(size_t)cu * 256 + tid] = ns; ns = al * ns + be * wsNLOC[(size_t)cu * 256 + tid]; }
                if (sl == 0 && tid == 0) wsMINB[cu] = m;
                m = mn;
            }
            float* oc = out + O_PC + (size_t)bh * 65536 + (size_t)v * 256 + k0;
            *(f32x4*)oc = (f32x4){cs[0], cs[1], cs[2], cs[3]}; *(f32x4*)(oc + 4) = (f32x4){cs[4], cs[5], cs[6], cs[7]};
            if (sl == 0 && tid < 256) out[O_PN + (size_t)bh * 256 + tid] = ns;
            if (sl == 0 && tid == 0) out[O_PM + bh] = m;
        }
        if (which == 2) for (int u = bid; u < 512; u += G) {
            const int sb = u >> 2, h = u & 3, m = MP + sb;
            LAS float* red = misc;
            LAS float* hv = misc + 16;
            __syncthreads();
            const float ig = wsGATES[(size_t)m * 8 + h] + args.in[I_BI][h], lf = logsigmoid_(wsGATES[(size_t)m * 8 + 4 + h] + args.in[I_BF][h]);
            const float mp = args.in[I_SMM][sb * 4 + h];
            const float inter = lf + mp, mt = fmaxf(inter, ig), wi = __expf(inter - mt), sd = __expf(ig - mt);
            const u32x2 qw = *(const u32x2*)(wsQm + (size_t)m * 1024 + h * 256 + 4 * lane), kw = *(const u32x2*)(wsKm + (size_t)m * 1024 + h * 256 + 4 * lane);
            const f32x4 qv = (f32x4){bflo(qw.x), bfhi(qw.x), bflo(qw.y), bfhi(qw.y)}, kv = (f32x4){bflo(kw.x), bfhi(kw.x), bflo(kw.y), bfhi(kw.y)};
            const f32x4 nv = *(const f32x4*)(args.in[I_SMN] + (size_t)u * 256 + 4 * lane);
            const float qk = wave_sum((qv[0] * kv[0] + qv[1] * kv[1]) + (qv[2] * kv[2] + qv[3] * kv[3]));
            const float nq = wave_sum((qv[0] * nv[0] + qv[1] * nv[1]) + (qv[2] * nv[2] + qv[3] * nv[3]));
            const float s = qk * sd, den = wi * nq + s, dn = fmaxf(fabsf(den), __expf(-mt));
            if (wave == 0) { *(f32x4*)(out + O_SN + (size_t)u * 256 + 4 * lane) = wi * nv + sd * kv; if (lane == 0) out[O_SM + u] = mt; }
            const float* Cs = args.in[I_SMC_] + (size_t)u * 65536; float* Co = out + O_SC + (size_t)u * 65536;
            float pc[32];
            const bf16_t* vrow = wsZ + (size_t)m * NZ + OFF_MV + h * 256 + 32 * wave;
#pragma unroll
            for (int r = 0; r < 32; ++r) {
                const int v = 32 * wave + r;
                const f32x4 c4 = __builtin_nontemporal_load((const f32x4*)(Cs + (size_t)v * 256 + 4 * lane));
                const float vv = bf2f(vrow[r]);
                pc[r] = (c4[0] * qv[0] + c4[1] * qv[1]) + (c4[2] * qv[2] + c4[3] * qv[3]);
                __builtin_nontemporal_store(wi * c4 + (sd * vv) * kv, (f32x4*)(Co + (size_t)v * 256 + 4 * lane));
            }
            reduce32(pc, lane);
            float hsq = 0.f;
            { const float vv = bf2f(vrow[lane >> 1]); const float hval = (wi * pc[0] + s * vv) / dn;
              if ((lane & 1) == 0) { hv[32 * wave + (lane >> 1)] = hval; hsq = hval * hval; } }
            hsq = wave_sum(hsq);
            if (lane == 0) red[wave] = hsq;
            __syncthreads();
            if (tid < 256) {
                float tot = 0.f;
#pragma unroll
                for (int w = 0; w < 8; ++w) tot += red[w];
                const float rstd = rsqrtf(tot * (1.f / 256.f) + EPS);
                const float og = bf2f(wsZ[(size_t)m * NZ + OFF_MO + h * 256 + tid]);
                wsY[(size_t)m * D + 1024 + h * 256 + tid] = (bf16_t)f2bf(hv[tid] * rstd * args.in[I_GML][tid] * sigmoidf_(og));
            }
        }
        }
        __syncthreads();
    }
    SEAM(5);

    REP(6) if (IN(6)) { PH_IDS
        for (int u = bid; u < 256; u += G) {
            const int bh = u >> 4, c = u & 15, b = bh >> 2, h = bh & 3, m0 = b * TT + c * 128;
            LAS float* ev = misc; LAS float* bb = misc + 128; LAS float* pmx = misc + 256; LAS float* nin = misc + 384;
            LAS unsigned char* Vl = lds;
            __syncthreads();
            if (tid < 128) { ev[tid] = wsGATES[(size_t)(m0 + tid) * 8 + h] + args.in[I_BI][h]; bb[tid] = logsigmoid_(wsGATES[(size_t)(m0 + tid) * 8 + 4 + h] + args.in[I_BF][h]); }
            if (tid >= 256) nin[tid - 256] = wsNIN[(size_t)u * 256 + tid - 256];
            __syncthreads();
            if (wave == 0) {
                const float x0 = bb[2 * lane], x1 = bb[2 * lane + 1], loc = x0 + x1; float inc = loc;
#pragma unroll
                for (int o = 1; o < 64; o <<= 1) { const float t = __shfl_up(inc, o); if (lane >= o) inc += t; }
                const float b0 = inc - x1, b1 = inc, e0 = ev[2 * lane] - b0, e1 = ev[2 * lane + 1] - b1;
                float im = fmaxf(e0, e1);
#pragma unroll
                for (int o = 1; o < 64; o <<= 1) { const float t = __shfl_up(im, o); if (lane >= o) im = fmaxf(im, t); }
                float ex = __shfl_up(im, 1); if (lane == 0) ex = -INFINITY;
                bb[2 * lane] = b0; bb[2 * lane + 1] = b1; ev[2 * lane] = e0; ev[2 * lane + 1] = e1;
                pmx[2 * lane] = fmaxf(ex, e0); pmx[2 * lane + 1] = im;
            }
            for (int idx = tid; idx < 128 * 32; idx += 512) { const int s = idx >> 5, ch = idx & 31;
                *(LAS u32x4*)(Vl + s * 528 + ch * 16) = *(const u32x4*)(wsZ + (size_t)(m0 + s) * NZ + OFF_MV + h * 256 + ch * 8); }
            __syncthreads();
            const float mc = wsMINB[u];
            const int fr = lane & 15, g4 = lane >> 4, q = fr >> 2, p = fr & 3, t = 16 * wave + fr;
            const bf16_t* qp = wsQm + (size_t)(m0 + t) * 1024 + h * 256 + 8 * g4;
            f32x4 sacc[8];
#pragma unroll
            for (int st = 0; st < 8; ++st) sacc[st] = (f32x4){0.f, 0.f, 0.f, 0.f};
#pragma unroll 2
            for (int ks = 0; ks < 8; ++ks) {
                const bf16x8 qf = ld8(qp + 32 * ks);
                const bf16_t* kp = wsKm + (size_t)(m0 + fr) * 1024 + h * 256 + 32 * ks + 8 * g4;
#pragma unroll
                for (int st = 0; st < 8; ++st) if (st <= wave) { const bf16x8 xk = ld8(kp + (size_t)(16 * st) * 1024); sacc[st] = MFMA16(xk, qf, sacc[st]); }
            }
            const float Mt = fmaxf(mc, pmx[t]);
            float rs = 0.f;
#pragma unroll
            for (int st = 0; st < 8; ++st) { const f32x4 e4 = *(const LAS f32x4*)(ev + 16 * st + 4 * g4);
#pragma unroll
                for (int r = 0; r < 4; ++r) { const int s = 16 * st + 4 * g4 + r; const float pv = (s <= t) ? sacc[st][r] * __expf(e4[r] - Mt) : 0.f; sacc[st][r] = pv; rs += pv; } }
            float nq = 0.f;
            f32x4 oacc[16];
#pragma unroll
            for (int vt = 0; vt < 16; ++vt) oacc[vt] = (f32x4){0.f, 0.f, 0.f, 0.f};
            const bf16_t* cin = wsCIN + (size_t)u * 65536 + (size_t)fr * 256 + 8 * g4;
#pragma unroll 2
            for (int ks = 0; ks < 8; ++ks) {
                const bf16x8 qf = ld8(qp + 32 * ks);
                const f32x4 n0 = *(const LAS f32x4*)(nin + 32 * ks + 8 * g4), n1 = *(const LAS f32x4*)(nin + 32 * ks + 8 * g4 + 4);
                nq += (bf2f((unsigned short)qf[0]) * n0[0] + bf2f((unsigned short)qf[1]) * n0[1]) + (bf2f((unsigned short)qf[2]) * n0[2] + bf2f((unsigned short)qf[3]) * n0[3])
                    + (bf2f((unsigned short)qf[4]) * n1[0] + bf2f((unsigned short)qf[5]) * n1[1]) + (bf2f((unsigned short)qf[6]) * n1[2] + bf2f((unsigned short)qf[7]) * n1[3]);
#pragma unroll
                for (int vt = 0; vt < 16; ++vt) { const bf16x8 xc = ld8(cin + (size_t)(16 * vt) * 256 + 32 * ks); oacc[vt] = MFMA16(xc, qf, oacc[vt]); }
            }
            rs += __shfl_xor(rs, 16); rs += __shfl_xor(rs, 32); nq += __shfl_xor(nq, 16); nq += __shfl_xor(nq, 32);
            const float wi = __expf(mc - Mt), den = wi * nq + rs, dn = fmaxf(fabsf(den), __expf(-(bb[t] + Mt)));
#pragma unroll
            for (int vt = 0; vt < 16; ++vt) oacc[vt] = oacc[vt] * wi;
#pragma unroll
            for (int pb = 0; pb < 4; ++pb) if (2 * pb <= wave) {
                u32x4 pw; pw.x = pk2(sacc[2 * pb][0], sacc[2 * pb][1]); pw.y = pk2(sacc[2 * pb][2], sacc[2 * pb][3]); pw.z = pk2(sacc[2 * pb + 1][0], sacc[2 * pb + 1][1]); pw.w = pk2(sacc[2 * pb + 1][2], sacc[2 * pb + 1][3]);
                const bf16x8 yp = __builtin_bit_cast(bf16x8, pw);
                const int rb = (32 * pb + 4 * g4 + q) * 528 + 8 * p;
#pragma unroll
                for (int vt = 0; vt < 16; ++vt) { const bf16x8 xv = cat8(tr_read(Vl + rb + 32 * vt), tr_read(Vl + rb + 16 * 528 + 32 * vt)); oacc[vt] = MFMA16(xv, yp, oacc[vt]); }
            }
            const float inv = 1.f / dn; float ss = 0.f;
#pragma unroll
            for (int vt = 0; vt < 16; ++vt) { oacc[vt] = oacc[vt] * inv; ss += (oacc[vt][0] * oacc[vt][0] + oacc[vt][1] * oacc[vt][1]) + (oacc[vt][2] * oacc[vt][2] + oacc[vt][3] * oacc[vt][3]); }
            ss += __shfl_xor(ss, 16); ss += __shfl_xor(ss, 32);
            const float rstd = rsqrtf(ss * (1.f / 256.f) + EPS);
#pragma unroll
            for (int vt = 0; vt < 16; ++vt) {
                const int v0 = 16 * vt + 4 * g4; const f32x4 gg = *(const f32x4*)(args.in[I_GML] + v0);
                const u32x2 ow = *(const u32x2*)(wsZ + (size_t)(m0 + t) * NZ + OFF_MO + h * 256 + v0);
                const float o0 = oacc[vt][0] * rstd * gg[0] * sigmoidf_(bflo(ow.x)), o1 = oacc[vt][1] * rstd * gg[1] * sigmoidf_(bfhi(ow.x));
                const float o2 = oacc[vt][2] * rstd * gg[2] * sigmoidf_(bflo(ow.y)), o3 = oacc[vt][3] * rstd * gg[3] * sigmoidf_(bfhi(ow.y));
                u32x2 w; w.x = pk2(o0, o1); w.y = pk2(o2, o3); *(u32x2*)(wsY + (size_t)(m0 + t) * D + 1024 + h * 256 + v0) = w;
            }
        }
        __syncthreads();
    }
    SEAM(6);

    REP(7) if (IN(7)) { PH_IDS
        { const pg8::Gemm g = pg8::mk_gemm(wsY, wsWoutT, D * 2, D * 2, D, 0); pg8::StaticOrder S; S.init(32, 8, G, bid);
          EpiResNorm<float> E{args.in[I_XP], wsX1, wsXN, args.in[I_GX], wsSS}; pg8::gemm_phase<EpiResNorm<float>, true, true>(lds, g, S, E, wave); }
        skinny_gemm(wsY + (size_t)MP * D, D, wsWoutT, D, D, D, 1, 0, 64, MP, FResNorm<float>{args.in[I_XS], MP, wsX1, wsXN, args.in[I_GX], wsSS}, 0, wave, (LAS float*)lds);
        if (bid >= 64) { convert_matrix(args.in[I_WCQ], D, D, D, wsWcqT, D, (LAS float*)(lds + wave * 16384), (bid - 64) * 8 + wave, (G - 64) * 8, lane);
                         convert_matrix(args.in[I_WCO], D, D, D, wsWcoT, D, (LAS float*)(lds + wave * 16384), (bid - 64) * 8 + wave, (G - 64) * 8, lane); }
    }
    SEAM(7);

    REP(9) if (IN(9)) { PH_IDS
        const float qs = 0.04419417382415922f;
        if (bid >= 64 && (bid & 1)) { convert_matrix(args.in[I_WUP], DFF, D, DFF, wsWupT, D, (LAS float*)(lds + wave * 16384), (bid - 64) * 8 + wave, (G - 64) * 8, lane); __syncthreads(); }
        { const pg8::Gemm g = pg8::mk_gemm(wsXN, wsWcqT, D * 2, D * 2, D, 0); pg8::StaticOrder S; S.init(32, 8, G, bid);
          pg8::EpiF8<FStoreBf16> E{{wsQC, D, qs, 0, wsSS}}; pg8::gemm_phase<pg8::EpiF8<FStoreBf16>, true, true>(lds, g, S, E, wave); }
        skinny_gemm(wsXN + (size_t)MP * D, D, wsWcqT, D, D, D, 1, 0, 64, MP, FStoreBf16{wsQC, D, qs, 0, wsSS}, 0, wave, (LAS float*)lds);
        if (bid >= 64 && !(bid & 1)) convert_matrix(args.in[I_WUP], DFF, D, DFF, wsWupT, D, (LAS float*)(lds + wave * 16384), (bid - 64) * 8 + wave, (G - 64) * 8, lane);
    }
    SEAM(9);

    REP(10) if (IN(10)) { PH_IDS
        { pg8::Gemm g{(const char*)wsQC, (const char*)wsMK, D * 2, D * 2, 512, (size_t)256 * D * 2, 0, 1024, 1024, (size_t)256 * D * 2, 0x7fffffff, 0x7fffffff, 0, 0}; pg8::StaticOrder S; S.init(32, 4, G, bid);
          EpiSoftmax E{wsPB, misc}; pg8::gemm_phase<EpiSoftmax, true, true>(lds, g, S, E, wave); }
        { pg8::Gemm g{(const char*)wsWcoT, (const char*)wsMVt, D * 2, D * 2, 512, (size_t)256 * D * 2, 0, 1024, 1024, 0, 3, 3, 2, (size_t)256 * D * 2}; pg8::StaticOrder S; S.init(8, 16, G, bid - 128);
          pg8::EpiF8<FVw> E{{wsVW}}; pg8::gemm_phase<pg8::EpiF8<FVw>, true, true>(lds, g, S, E, wave); }
        for (int u = bid; u < 512; u += G) {
            const int sb = u >> 2, h = u & 3, m = MP + sb;
            LAS float* scr = misc;
            LAS float* part = (LAS float*)lds;
            __syncthreads();
            const u32x2 qa = *(const u32x2*)(wsQC + (size_t)m * D + h * 512 + 4 * lane), qb = *(const u32x2*)(wsQC + (size_t)m * D + h * 512 + 256 + 4 * lane);
            const f32x4 q0 = (f32x4){bflo(qa.x), bfhi(qa.x), bflo(qa.y), bfhi(qa.y)}, q1 = (f32x4){bflo(qb.x), bfhi(qb.x), bflo(qb.y), bfhi(qb.y)};
            const float* kb = args.in[I_CK] + ((size_t)sb * 256 * 4 + h) * 512 + 4 * lane + (size_t)(32 * wave) * 2048;
            const float* vb = args.in[I_CV] + ((size_t)sb * 256 * 4 + h) * 512 + 4 * lane + (size_t)(32 * wave) * 2048;
            float pa[32];
#pragma unroll
            for (int i = 0; i < 32; ++i) { const f32x4 a = __builtin_nontemporal_load((const f32x4*)(kb + (size_t)i * 2048)), c4 = __builtin_nontemporal_load((const f32x4*)(kb + (size_t)i * 2048 + 256));
                pa[i] = ((a[0] * q0[0] + a[1] * q0[1]) + (a[2] * q0[2] + a[3] * q0[3])) + ((c4[0] * q1[0] + c4[1] * q1[1]) + (c4[2] * q1[2] + c4[3] * q1[3])); }
            reduce32(pa, lane);
            if ((lane & 1) == 0) scr[32 * wave + (lane >> 1)] = pa[0];
            __syncthreads();
            const f32x4 s4 = *(const LAS f32x4*)(scr + 4 * lane);
            const float mx = wave_max(fmaxf(fmaxf(s4[0], s4[1]), fmaxf(s4[2], s4[3])));
            const float sm = wave_sum((__expf(s4[0] - mx) + __expf(s4[1] - mx)) + (__expf(s4[2] - mx) + __expf(s4[3] - mx)));
            const float inv = 1.f / sm;
            f32x4 o0 = (f32x4){0.f, 0.f, 0.f, 0.f}, o1 = (f32x4){0.f, 0.f, 0.f, 0.f};
#pragma unroll 16
            for (int i = 0; i < 32; ++i) { const float pr = __expf(scr[32 * wave + i] - mx) * inv;
                const f32x4 a = __builtin_nontemporal_load((const f32x4*)(vb + (size_t)i * 2048)), c4 = __builtin_nontemporal_load((const f32x4*)(vb + (size_t)i * 2048 + 256));
                o0 = o0 + pr * a; o1 = o1 + pr * c4; }
            *(LAS f32x4*)(part + wave * 512 + 4 * lane) = o0; *(LAS f32x4*)(part + wave * 512 + 256 + 4 * lane) = o1;
            __syncthreads();
            float tot = 0.f;
#pragma unroll
            for (int w = 0; w < 8; ++w) tot += part[w * 512 + tid];
            wsOC[(size_t)m * D + h * 512 + tid] = (bf16_t)f2bf(tot);
        }
        __syncthreads();
    }
    SEAM(10);

    REP(11) if (IN(11)) { PH_IDS
        if (bid >= 64 && (bid & 1)) { convert_matrix(args.in[I_WDN], D, DFF, D, wsWdnT, DFF, (LAS float*)(lds + wave * 16384), (bid - 64) * 8 + wave, (G - 64) * 8, lane); __syncthreads(); }
        { pg8::Gemm g{(const char*)wsPB, (const char*)wsVW, 2048, 2048, 1024, (size_t)256 * 2048, 0, 0, (size_t)256 * 2048, (size_t)D * 2048, 0x7fffffff, 0x7fffffff, 0, 0}; pg8::StaticOrder S; S.init(32, 8, G, bid);
          EpiResNorm<bf16_t> E{wsX1, wsX2, wsXN, args.in[I_GFFN], wsSS + MT}; pg8::gemm_phase<EpiResNorm<bf16_t>, true, true>(lds, g, S, E, wave); }
        skinny_gemm(wsOC + (size_t)MP * D, D, wsWcoT, D, D, D, 1, 0, 64, MP, FResNorm<bf16_t>{wsX1, 0, wsX2, wsXN, args.in[I_GFFN], wsSS + MT}, 0, wave, (LAS float*)lds);
        if (bid >= 64 && !(bid & 1)) convert_matrix(args.in[I_WDN], D, DFF, D, wsWdnT, DFF, (LAS float*)(lds + wave * 16384), (bid - 64) * 8 + wave, (G - 64) * 8, lane);
    }
    SEAM(11);

    REP(13) if (IN(13)) { PH_IDS
        { const pg8::Gemm g = pg8::mk_gemm(wsXN, wsWupT, D * 2, D * 2, D, 0); pg8::StaticOrder S; S.init(32, 32, G, bid);
          pg8::EpiF8<FStoreBf16> E{{wsU, DFF, 1.f, 1, wsSS + MT}}; pg8::gemm_phase<pg8::EpiF8<FStoreBf16>, true, true>(lds, g, S, E, wave); }
        skinny_gemm(wsXN + (size_t)MP * D, D, wsWupT, D, D, DFF, 1, 0, 256, MP, FStoreBf16{wsU, DFF, 1.f, 1, wsSS + MT}, 0, wave, (LAS float*)lds);
    }
    SEAM(13);

    REP(14) if (IN(14)) { PH_IDS
        { const pg8::Gemm g = pg8::mk_gemm(wsU, wsWdnT, DFF * 2, DFF * 2, DFF, 0); pg8::StaticOrder S; S.init(32, 8, G, bid);
          pg8::EpiF8<FResB> E{{wsX2, wsX1}}; pg8::gemm_phase<pg8::EpiF8<FResB>, true, true>(lds, g, S, E, wave); }
        skinny_gemm(wsU + (size_t)MP * DFF, DFF, wsWdnT, DFF, DFF, D, 4, 0, 256, 0, FPart{wsPART, D}, 128, wave, (LAS float*)lds);
    }
    SEAM(14);

    REP(15) if (IN(15)) { PH_IDS
        f32x4 gfin[8]; load_gain(args.in[I_GFIN], lane, gfin);
        for (int m = gw; m < MT; m += NGW) {
            f32x4 v[8]; float ss = 0.f;
#pragma unroll
            for (int j = 0; j < 8; ++j) {
                if (m < MP) v[j] = ld4_res(wsX1 + (size_t)m * D + 256 * j + 4 * lane);
                else { const size_t o = (size_t)(m - MP) * D + 256 * j + 4 * lane; v[j] = ld4_res(wsX2 + (size_t)m * D + 256 * j + 4 * lane);
#pragma unroll
                    for (int s = 0; s < 4; ++s) v[j] = v[j] + *(const f32x4*)(wsPART + (size_t)s * 128 * D + o); }
                ss += (v[j][0] * v[j][0] + v[j][1] * v[j][1]) + (v[j][2] * v[j][2] + v[j][3] * v[j][3]);
            }
            const float rstd = rsqrtf(wave_sum(ss) * (1.f / D) + EPS);
            float* o = (m < MP) ? out + O_YP + (size_t)m * D : out + O_YS + (size_t)(m - MP) * D;
#pragma unroll
            for (int j = 0; j < 8; ++j) __builtin_nontemporal_store(v[j] * rstd * gfin[j], (f32x4*)(o + 256 * j + 4 * lane));
        }
    }
#undef IN
#undef SEAM
}

extern "C" void kernel_launch(void* const* d_in, const int* in_sizes, int n_in, void* d_out, int out_size, void* d_ws, size_t ws_size, hipStream_t stream) {
    static int grid = 0;
    if (grid == 0) {
        int dev = 0, cus = 0, per_cu = 0;
        if (n_in != 39 || ws_size < WS_END) { fprintf(stderr, "kernel_launch: unexpected n_in %d / ws %zu\n", n_in, ws_size); grid = -1; return; }
        hipGetDevice(&dev);
        hipDeviceGetAttribute(&cus, hipDeviceAttributeMultiprocessorCount, dev);
        if (hipFuncSetAttribute((const void*)mega_fwd, hipFuncAttributeMaxDynamicSharedMemorySize, LDS_BYTES) != hipSuccess) { fprintf(stderr, "kernel_launch: hipFuncSetAttribute failed\n"); grid = -1; return; }
        if (hipOccupancyMaxActiveBlocksPerMultiprocessor(&per_cu, (const void*)mega_fwd, 512, LDS_BYTES) != hipSuccess || per_cu < 1) { fprintf(stderr, "kernel_launch: occupancy query says %d\n", per_cu); per_cu = 1; }
        (void)hipGetLastError();
        grid = cus;
    }
    if (grid < 0) return;
    Args a{};
    for (int i = 0; i < 39; ++i) a.in[i] = (const float*)d_in[i];
    a.out = (float*)d_out; a.ws = (unsigned char*)d_ws; a.ph_lo = 0; a.ph_hi = NPH;
    if (hipMemsetAsync((char*)d_ws + WS_CTL, 0, 65536, stream) != hipSuccess) { fprintf(stderr, "kernel_launch: memset failed\n"); return; }
    hipLaunchKernelGGL(mega_fwd, dim3(grid), dim3(512), LDS_BYTES, stream, a);
    hipError_t e = hipPeekAtLastError();
    if (e != hipSuccess) fprintf(stderr, "kernel_launch: launch failed: %s (grid %d)\n", hipGetErrorString(e), grid);
}
```

```cpp
#include <hip/hip_runtime.h>
#include <cstdio>
#include <cstdint>

#define LAS __attribute__((address_space(3)))
typedef unsigned short bf16_t;
typedef short bf16x8 __attribute__((ext_vector_type(8)));
typedef short s16x4 __attribute__((ext_vector_type(4)));
typedef float f32x4 __attribute__((ext_vector_type(4)));
typedef float f32x2 __attribute__((ext_vector_type(2)));
typedef unsigned u32x4 __attribute__((ext_vector_type(4)));
typedef unsigned u32x2 __attribute__((ext_vector_type(2)));

constexpr int D = 2048, NB = 4, TT = 2048, MP = NB * TT, MS = 128, MT = MP + MS;
constexpr int DIN = 5128, NZ = 5120, NZP = 5376, DR = 1024, DFF = 8192, NMEM = 256, MMEM = NB * NMEM;
constexpr float EPS = 1e-6f;
constexpr int OFF_RX = 0, OFF_RG = 1024, OFF_MU = 2048, OFF_MV = 3072, OFF_MO = 4096;
constexpr size_t O_YP = 0;
constexpr size_t O_YS = O_YP + (size_t)MP * D;
constexpr size_t O_PH = O_YS + (size_t)MS * D;
constexpr size_t O_PRC = O_PH + 4 * 1024;
constexpr size_t O_PC = O_PRC + 4 * 3 * 1024;
constexpr size_t O_PN = O_PC + (size_t)4 * 4 * 65536;
constexpr size_t O_PM = O_PN + 4 * 4 * 256;
constexpr size_t O_PMC = O_PM + 16;
constexpr size_t O_PK = O_PMC + 4 * 3 * 1024;
constexpr size_t O_PV = O_PK + (size_t)MMEM * D;
constexpr size_t O_SH = O_PV + (size_t)MMEM * D;
constexpr size_t O_SRC = O_SH + 128 * 1024;
constexpr size_t O_SC = O_SRC + 128 * 3 * 1024;
constexpr size_t O_SN = O_SC + (size_t)128 * 4 * 65536;
constexpr size_t O_SM = O_SN + 128 * 4 * 256;
constexpr size_t O_SMC = O_SM + 512;
constexpr size_t MiB = 1u << 20;
constexpr size_t WS_WIN = 0, WS_WOUT = 20 * MiB, WS_WCQ = 28 * MiB, WS_WMK = 36 * MiB, WS_WMV = 44 * MiB, WS_WCO = 52 * MiB;
constexpr size_t WS_WUP = 60 * MiB, WS_WDN = 92 * MiB, WS_WG = 124 * MiB, WS_WQK = 125 * MiB, WS_XN = 126 * MiB, WS_MN = 159 * MiB;
constexpr size_t WS_Z = 163 * MiB, WS_GATES = 245 * MiB, WS_XC = 246 * MiB, WS_UC = 263 * MiB, WS_AU = 280 * MiB, WS_QM = 345 * MiB;
constexpr size_t WS_KM = 362 * MiB, WS_Y = 379 * MiB, WS_X1 = 412 * MiB, WS_X2 = 477 * MiB, WS_QC = 542 * MiB, WS_OC = 575 * MiB;
constexpr size_t WS_MK = 608 * MiB, WS_MVT = 612 * MiB, WS_U = 616 * MiB, WS_CLOC = 746 * MiB, WS_CIN = 778 * MiB, WS_NLOC = 810 * MiB;
constexpr size_t WS_NIN = 811 * MiB, WS_MSTAT = 812 * MiB, WS_SUM = 813 * MiB, WS_PART = 815 * MiB, WS_CTL = 819 * MiB, WS_WIN2 = 820 * MiB, WS_END = 842 * MiB;
constexpr int LDS_BYTES = 147712, MISC_OFF = 139264;
constexpr int NPH = 16;

__device__ __forceinline__ unsigned f2bf(float f) { unsigned u = __builtin_bit_cast(unsigned, f); return (u + 0x7fffu + ((u >> 16) & 1u)) >> 16; }
__device__ __forceinline__ unsigned pk2(float lo, float hi) { return f2bf(lo) | (f2bf(hi) << 16); }
__device__ __forceinline__ float bf2f(unsigned h) { return __builtin_bit_cast(float, (h & 0xffffu) << 16); }
__device__ __forceinline__ float bflo(unsigned w) { return __builtin_bit_cast(float, w << 16); }
__device__ __forceinline__ float bfhi(unsigned w) { return __builtin_bit_cast(float, w & 0xffff0000u); }
__device__ __forceinline__ float wave_sum(float v) {
#pragma unroll
    for (int o = 1; o < 64; o <<= 1) v += __shfl_xor(v, o);
    return v;
}
__device__ __forceinline__ float wave_max(float v) {
#pragma unroll
    for (int o = 1; o < 64; o <<= 1) v = fmaxf(v, __shfl_xor(v, o));
    return v;
}
__device__ __forceinline__ void reduce32(float (&a)[32], int lane) {
#pragma unroll
    for (int i = 0; i < 16; ++i) { const bool up = lane & 32; const float keep = up ? a[i + 16] : a[i], send = up ? a[i] : a[i + 16]; a[i] = keep + __shfl_xor(send, 32); }
#pragma unroll
    for (int i = 0; i < 8; ++i) { const bool up = lane & 16; const float keep = up ? a[i + 8] : a[i], send = up ? a[i] : a[i + 8]; a[i] = keep + __shfl_xor(send, 16); }
#pragma unroll
    for (int i = 0; i < 4; ++i) { const bool up = lane & 8; const float keep = up ? a[i + 4] : a[i], send = up ? a[i] : a[i + 4]; a[i] = keep + __shfl_xor(send, 8); }
#pragma unroll
    for (int i = 0; i < 2; ++i) { const bool up = lane & 4; const float keep = up ? a[i + 2] : a[i], send = up ? a[i] : a[i + 2]; a[i] = keep + __shfl_xor(send, 4); }
    { const bool up = lane & 2; const float keep = up ? a[1] : a[0], send = up ? a[0] : a[1]; a[0] = keep + __shfl_xor(send, 2); }
    a[0] += __shfl_xor(a[0], 1);
}
__device__ __forceinline__ float sigmoidf_(float x) { return 1.f / (1.f + __expf(-x)); }
__device__ __forceinline__ float gelu_tanh(float x) { const float u = 0.7978845608028654f * (x + 0.044715f * x * x * x); return 0.5f * x * (1.f + tanhf(u)); }
__device__ __forceinline__ float logsigmoid_(float x) { return fminf(x, 0.f) - log1pf(__expf(-fabsf(x))); }
__device__ __forceinline__ bf16x8 ld8(const bf16_t* p) { return *(const bf16x8*)p; }
__device__ __forceinline__ s16x4 tr_read(const LAS unsigned char* p) {
    typedef short v4i16_t __attribute__((ext_vector_type(4)));
    return __builtin_bit_cast(s16x4, __builtin_amdgcn_ds_read_tr16_b64_v4i16((LAS v4i16_t*)p));
}
__device__ __forceinline__ bf16x8 cat8(s16x4 a, s16x4 b) { return (bf16x8){a[0], a[1], a[2], a[3], b[0], b[1], b[2], b[3]}; }
__device__ __forceinline__ int lane_id() { int l; asm volatile("v_mbcnt_lo_u32_b32 %0, -1, 0\n\tv_mbcnt_hi_u32_b32 %0, -1, %0" : "=v"(l)); return l; }
#define MFMA16(x, y, c) __builtin_amdgcn_mfma_f32_16x16x32_bf16((x), (y), (c), 0, 0, 0)

namespace pg8 {
constexpr int BM = 256, BK = 64, HALF = 128, HTB = HALF * BK * 2, STAGE_BYTES = 8 * HTB, NXCD = 8, WGM = 8;
__host__ __device__ __forceinline__ int lds_byte(int r, int c) { const int st = (r >> 4) * 2 + (c >> 5), rr = r & 15, cc = c & 31, ob = rr * 64 + cc * 2; return st * 1024 + (ob ^ (((ob >> 9) & 1) << 5)); }
__host__ __device__ __forceinline__ void stage_rc(int b, int& R, int& C) { const int st = b / 1024, sb = b % 1024, swz = sb ^ (((sb >> 9) & 1) << 5); R = (st >> 1) * 16 + swz / 64; C = (st & 1) * 32 + (swz % 64) / 2; }
__host__ __device__ __forceinline__ int perm32(int rho) { const int n = rho >> 4, i = rho & 15; return 8 * (i >> 2) + 4 * n + (i & 3); }
struct Unit { int pm, pn; };
struct Gemm { const char* A; const char* B; int lda, ldb  , K; size_t a_pm; int a_sh; size_t a_pn, b_pn, b_pm8; int a_msk, b_msk, b_sh2; size_t b_pn2; };
__device__ __forceinline__ Gemm mk_gemm(const void* A, const void* B, int lda, int ldb, int K, int acs) { return Gemm{(const char*)A, (const char*)B, lda, ldb, K, (size_t)256 * lda, 1, (size_t)acs, (size_t)256 * ldb, 0, 0x7fffffff, 0x7fffffff, 0, 0}; }
struct StaticOrder {
    int nM, nN, nwg, G, c;
    __device__ void init(int nM_, int nN_, int G_, int c_) { nM = nM_; nN = nN_; nwg = nM * nN; G = G_; c = c_; }
    __device__ bool next(int i, Unit& u) const {
        if (c < 0 || c >= G) return false;
        const long L = (long)i * G + c; if (L >= nwg) return false;
        int wgid = (int)L; { const int q = nwg / NXCD, r = nwg % NXCD, xcd = wgid % NXCD, off = wgid / NXCD; wgid = (xcd < r ? xcd * (q + 1) : r * (q + 1) + (xcd - r) * q) + off; }
        const int nig = WGM * nN, gid = wgid / nig, fm = gid * WGM, gsz = (nM - fm) < WGM ? (nM - fm) : WGM;
        u.pm = fm + ((wgid % nig) % gsz); u.pn = (wgid % nig) / gsz; return true;
    }
};
template <class F> struct EpiF8 {
    static constexpr bool PERM = true;
    F f;
    __device__ __forceinline__ void operator()(const f32x4 (&acc)[2][2][4][2], const Unit& u, int wr, int wc, int fr, int fq) const {
        float rs[2][4];
#pragma unroll
        for (int ai = 0; ai < 2; ++ai)
#pragma unroll
            for (int m = 0; m < 4; ++m) rs[ai][m] = f.rowscale(u.pm * BM + ai * HALF + wr * 64 + m * 16 + fr);
#pragma unroll
        for (int ai = 0; ai < 2; ++ai)
#pragma unroll
            for (int m = 0; m < 4; ++m) {
                const int row = u.pm * BM + ai * HALF + wr * 64 + m * 16 + fr;
#pragma unroll
                for (int bj = 0; bj < 2; ++bj) f.f8(row, u.pn * BM + bj * HALF + wc * 32 + 8 * fq, acc[ai][bj][m][0] * rs[ai][m], acc[ai][bj][m][1] * rs[ai][m]);
            }
    }
};
template <class F> struct EpiF {
    static constexpr bool PERM = false;
    F f;
    __device__ __forceinline__ void operator()(const f32x4 (&acc)[2][2][4][2], const Unit& u, int wr, int wc, int fr, int fq) const {
        float rs[2][4];
#pragma unroll
        for (int ai = 0; ai < 2; ++ai)
#pragma unroll
            for (int m = 0; m < 4; ++m) rs[ai][m] = f.rowscale(u.pm * BM + ai * HALF + wr * 64 + m * 16 + fr);
#pragma unroll
        for (int ai = 0; ai < 2; ++ai)
#pragma unroll
            for (int m = 0; m < 4; ++m) {
                const int row = u.pm * BM + ai * HALF + wr * 64 + m * 16 + fr;
#pragma unroll
                for (int bj = 0; bj < 2; ++bj)
#pragma unroll
                    for (int n = 0; n < 2; ++n) f(row, u.pn * BM + bj * HALF + wc * 32 + n * 16 + 4 * fq, acc[ai][bj][m][n] * rs[ai][m]);
            }
    }
};

template <class Epi, bool ALIGN_EPI, bool SP2>
__device__ __forceinline__ void gemm_phase(LAS unsigned char* lds, const Gemm g, const StaticOrder& S, const Epi& E, const int wid) {
    const int lane = lane_id(), tid = wid * 64 + lane, wr = wid >> 2, wc = wid & 3, fr = lane & 15, fq = lane >> 4;
    const int K = g.K, nt = K / BK;
    unsigned voffA[2], voffB[2];
#pragma unroll
    for (int i = 0; i < 2; ++i) { int R, C; stage_rc(tid * 16 + i * 8192, R, C); const int Rb = Epi::PERM ? ((R & ~31) + perm32(R & 31)) : R; voffA[i] = (unsigned)(R * g.lda + C * 2); voffB[i] = (unsigned)(Rb * g.ldb + C * 2); }
    const size_t kstep = (size_t)(BK * 2);
    const size_t hstepA = (size_t)HALF * g.lda, hstepB = (size_t)HALF * g.ldb;
    const unsigned ldsw = (unsigned)wid * 1024u;
    const int aoff = lds_byte(wr * 64 + fr, fq * 8), boff = lds_byte(wc * 32 + fr, fq * 8);
#define PG8_SA(b, h) (((b) * 2 + (h)) * HTB)
#define PG8_SB(b, h) ((4 + (b) * 2 + (h)) * HTB)
#define PG8_STAGE(bufoff, gbase, voff) do { _Pragma("unroll") for (int _i = 0; _i < 2; ++_i) \
        __builtin_amdgcn_global_load_lds((const unsigned*)((const char*)(gbase) + (voff)[_i]), (LAS unsigned*)(lds + (bufoff) + ldsw + _i * 8192), 16, 0, 0); } while (0)
#define PG8_LDA(dst, b, h) do { _Pragma("unroll") for (int m = 0; m < 4; ++m) _Pragma("unroll") for (int k = 0; k < 2; ++k) dst[m][k] = *(const LAS bf16x8*)(lds + PG8_SA(b, h) + aoff + m * 2048 + k * 1024); } while (0)
#define PG8_LDB(dst, b, h) do { _Pragma("unroll") for (int n = 0; n < 2; ++n) _Pragma("unroll") for (int k = 0; k < 2; ++k) dst[n][k] = *(const LAS bf16x8*)(lds + PG8_SB(b, h) + boff + n * 2048 + k * 1024); } while (0)
#define PG8_MMA(ai, bj, At, Bt) do { __builtin_amdgcn_s_setprio(1); _Pragma("unroll") for (int m = 0; m < 4; ++m) _Pragma("unroll") for (int n = 0; n < 2; ++n) _Pragma("unroll") for (int k = 0; k < 2; ++k) \
        acc[ai][bj][m][n] = __builtin_amdgcn_mfma_f32_16x16x32_bf16(Bt[n][k], At[m][k], acc[ai][bj][m][n], 0, 0, 0); __builtin_amdgcn_s_setprio(0); } while (0)
#define PG8_WAIT_V(n) asm volatile("s_waitcnt vmcnt(" #n ")" ::: "memory")
#define PG8_WAIT_L(n) asm volatile("s_waitcnt lgkmcnt(" #n ")" ::: "memory")
#define PG8_BAR __builtin_amdgcn_s_barrier()
#define PG8_SCHED __builtin_amdgcn_sched_barrier(0)
#define PG8_APTR(u) (g.A + (size_t)(u).pm * g.a_pm + (size_t)(((u).pn >> g.a_sh) & g.a_msk) * g.a_pn)
#define PG8_BPTR(u) (g.B + (size_t)((u).pn & g.b_msk) * g.b_pn + (size_t)((u).pn >> g.b_sh2) * g.b_pn2 + (size_t)((u).pm >> 3) * g.b_pm8)
    Unit cur, nxt; int ui = 0;
    if (!S.next(0, cur)) return;
    f32x4 acc[2][2][4][2];
#pragma unroll
    for (int a = 0; a < 2; ++a)
#pragma unroll
        for (int b = 0; b < 2; ++b)
#pragma unroll
            for (int m = 0; m < 4; ++m)
#pragma unroll
                for (int n = 0; n < 2; ++n) acc[a][b][m][n] = (f32x4){0.f, 0.f, 0.f, 0.f};
    bf16x8 At[4][2], B0[2][2], B1[2][2];
    const char* cA = PG8_APTR(cur); const char* cB = PG8_BPTR(cur);
    if constexpr (SP2) {
        PG8_STAGE(PG8_SB(0, 0), cB, voffB); PG8_STAGE(PG8_SB(0, 1), cB + hstepB, voffB); PG8_STAGE(PG8_SA(0, 0), cA, voffA); PG8_STAGE(PG8_SA(0, 1), cA + hstepA, voffA);
        if (wr == 1) PG8_BAR;
        PG8_WAIT_V(2); PG8_BAR;
        PG8_STAGE(PG8_SB(1, 0), cB + kstep, voffB); PG8_STAGE(PG8_SA(1, 0), cA + kstep, voffA); PG8_STAGE(PG8_SB(1, 1), cB + hstepB + kstep, voffB);
        PG8_WAIT_V(6); PG8_BAR;
    } else {
        PG8_STAGE(PG8_SB(0, 0), cB, voffB); PG8_STAGE(PG8_SA(0, 0), cA, voffA); PG8_STAGE(PG8_SB(0, 1), cB + hstepB, voffB); PG8_STAGE(PG8_SA(0, 1), cA + hstepA, voffA);
        if (wr == 1) PG8_BAR;
        PG8_WAIT_V(4); PG8_BAR;
        PG8_STAGE(PG8_SB(1, 0), cB + kstep, voffB); PG8_STAGE(PG8_SA(1, 0), cA + kstep, voffA); PG8_STAGE(PG8_SB(1, 1), cB + hstepB + kstep, voffB);
        PG8_WAIT_V(6); PG8_BAR;
    }
    for (;;) {
        const bool has_next = S.next(ui + 1, nxt);
        const char* nA = has_next ? PG8_APTR(nxt) : cA; const char* nB = has_next ? PG8_BPTR(nxt) : cB;
#pragma nounroll
        for (int t = 0; t < nt; t += 2) {
            const bool last = (t == nt - 2);
            const char* a1 = cA + (size_t)(t + 1) * kstep;
            const char* a2 = last ? nA : cA + (size_t)(t + 2) * kstep; const char* b2 = last ? nB : cB + (size_t)(t + 2) * kstep;
            const char* a3 = a2 + kstep; const char* b3 = b2 + kstep;
            if constexpr (SP2) {
            PG8_LDB(B0, 0, 0); PG8_LDB(B1, 0, 1); PG8_SCHED; PG8_LDA(At, 0, 0); PG8_STAGE(PG8_SA(1, 1), a1 + hstepA, voffA);
            PG8_WAIT_V(8); PG8_WAIT_L(0); PG8_BAR; PG8_MMA(0, 0, At, B0); PG8_MMA(0, 1, At, B1); PG8_BAR; PG8_SCHED;
            PG8_LDA(At, 0, 1); PG8_STAGE(PG8_SB(0, 0), b2, voffB); PG8_STAGE(PG8_SB(0, 1), b2 + hstepB, voffB); PG8_STAGE(PG8_SA(0, 0), a2, voffA);
            PG8_WAIT_V(8); PG8_WAIT_L(0); PG8_BAR; PG8_MMA(1, 0, At, B0); PG8_MMA(1, 1, At, B1); PG8_BAR; PG8_SCHED;
            PG8_LDB(B0, 1, 0); PG8_LDB(B1, 1, 1); PG8_SCHED; PG8_LDA(At, 1, 0); PG8_STAGE(PG8_SA(0, 1), a2 + hstepA, voffA);
            PG8_WAIT_V(8); PG8_WAIT_L(0); PG8_BAR; PG8_MMA(0, 0, At, B0); PG8_MMA(0, 1, At, B1); PG8_BAR; PG8_SCHED;
            PG8_LDA(At, 1, 1); PG8_STAGE(PG8_SB(1, 0), b3, voffB); PG8_STAGE(PG8_SB(1, 1), b3 + hstepB, voffB); PG8_STAGE(PG8_SA(1, 0), a3, voffA);
            PG8_WAIT_V(8); PG8_WAIT_L(0); PG8_BAR; PG8_MMA(1, 0, At, B0); PG8_MMA(1, 1, At, B1); PG8_BAR; PG8_SCHED;
            } else {
            PG8_LDB(B0, 0, 0); PG8_SCHED; PG8_LDA(At, 0, 0); PG8_STAGE(PG8_SA(1, 1), a1 + hstepA, voffA);
            PG8_WAIT_L(8); PG8_BAR; PG8_WAIT_L(0); PG8_MMA(0, 0, At, B0); PG8_BAR; PG8_SCHED;
            PG8_LDB(B1, 0, 1); PG8_STAGE(PG8_SB(0, 0), b2, voffB);
            PG8_BAR; PG8_WAIT_L(0); PG8_MMA(0, 1, At, B1); PG8_BAR;
            PG8_LDA(At, 0, 1); PG8_STAGE(PG8_SA(0, 0), a2, voffA);
            PG8_BAR; PG8_WAIT_L(0); PG8_MMA(1, 0, At, B0); PG8_BAR; PG8_SCHED;
            PG8_STAGE(PG8_SB(0, 1), b2 + hstepB, voffB);
            PG8_WAIT_V(6); PG8_BAR; PG8_MMA(1, 1, At, B1); PG8_BAR;
            PG8_LDB(B0, 1, 0); PG8_SCHED; PG8_LDA(At, 1, 0); PG8_STAGE(PG8_SA(0, 1), a2 + hstepA, voffA);
            PG8_WAIT_L(8); PG8_BAR; PG8_WAIT_L(0); PG8_MMA(0, 0, At, B0); PG8_BAR; PG8_SCHED;
            PG8_LDB(B1, 1, 1); PG8_STAGE(PG8_SB(1, 0), b3, voffB);
            PG8_BAR; PG8_WAIT_L(0); PG8_MMA(0, 1, At, B1); PG8_BAR;
            PG8_LDA(At, 1, 1); PG8_STAGE(PG8_SA(1, 0), a3, voffA);
            PG8_BAR; PG8_WAIT_L(0); PG8_MMA(1, 0, At, B0); PG8_BAR; PG8_SCHED;
            PG8_STAGE(PG8_SB(1, 1), b3 + hstepB, voffB);
            PG8_WAIT_V(6); PG8_BAR; PG8_MMA(1, 1, At, B1); PG8_BAR;
            }
        }
        if constexpr (ALIGN_EPI) { if (wr == 0) PG8_BAR; }
        E(acc, cur, wr, wc, fr, fq);
        if (!has_next) break;
#pragma unroll
        for (int a = 0; a < 2; ++a)
#pragma unroll
            for (int b = 0; b < 2; ++b)
#pragma unroll
                for (int m = 0; m < 4; ++m)
#pragma unroll
                    for (int n = 0; n < 2; ++n) acc[a][b][m][n] = (f32x4){0.f, 0.f, 0.f, 0.f};
        cur = nxt; cA = nA; cB = nB; ++ui;
        if constexpr (ALIGN_EPI) { if (wr == 1) PG8_BAR; }
    }
    PG8_WAIT_V(0);
    if constexpr (!ALIGN_EPI) { if (wr == 0) PG8_BAR; }
    PG8_BAR;
#undef PG8_SA
#undef PG8_SB
#undef PG8_STAGE
#undef PG8_LDA
#undef PG8_LDB
#undef PG8_MMA
#undef PG8_WAIT_V
#undef PG8_WAIT_L
#undef PG8_BAR
#undef PG8_SCHED
#undef PG8_APTR
#undef PG8_BPTR
}
}

struct FStoreBf16 { bf16_t* O; int ld; float scale; int act; const float* ss;
    __device__ __forceinline__ float rowscale(int row) const { return ss ? scale * rsqrtf(ss[row] * (1.f / D) + EPS) : scale; }
    __device__ __forceinline__ void operator()(int row, int col, f32x4 v) const {
        if (act == 1) {
#pragma unroll
            for (int e = 0; e < 4; ++e) { const float r = fmaxf(v[e], 0.f); v[e] = r * r; }
        }
        u32x2 w; w.x = pk2(v[0], v[1]); w.y = pk2(v[2], v[3]); *(u32x2*)(O + (size_t)row * ld + col) = w; }
    __device__ __forceinline__ void f8(int row, int col, f32x4 a, f32x4 b) const {
        if (act == 1) {
#pragma unroll
            for (int e = 0; e < 4; ++e) { const float r = fmaxf(a[e], 0.f); a[e] = r * r; const float s = fmaxf(b[e], 0.f); b[e] = s * s; }
        }
        u32x4 w; w.x = pk2(a[0], a[1]); w.y = pk2(a[2], a[3]); w.z = pk2(b[0], b[1]); w.w = pk2(b[2], b[3]); *(u32x4*)(O + (size_t)row * ld + col) = w; } };
struct FResF32 { const float* base; int brow0; float* out; int ld;
    __device__ __forceinline__ float rowscale(int) const { return 1.f; }
    __device__ __forceinline__ void operator()(int row, int col, f32x4 v) const {
        const f32x4 b = *(const f32x4*)(base + (size_t)(row - brow0) * ld + col); *(f32x4*)(out + (size_t)row * ld + col) = b + v; } };
struct FZ { bf16_t* Zp; float* Gp;
    __device__ __forceinline__ float rowscale(int) const { return 1.f; }
    __device__ __forceinline__ void operator()(int row, int col, f32x4 v) const {
        if (row >= MT) return;
        if (col < NZ) { u32x2 w; w.x = pk2(v[0], v[1]); w.y = pk2(v[2], v[3]); *(u32x2*)(Zp + (size_t)row * NZ + col) = w; }
        else if (col < NZ + 8) *(f32x4*)(Gp + (size_t)row * 8 + (col - NZ)) = v; }
    __device__ __forceinline__ void f8(int row, int col, f32x4 a, f32x4 b) const {
        if (row >= MT) return;
        if (col < NZ) { u32x4 w; w.x = pk2(a[0], a[1]); w.y = pk2(a[2], a[3]); w.z = pk2(b[0], b[1]); w.w = pk2(b[2], b[3]); *(u32x4*)(Zp + (size_t)row * NZ + col) = w; }
        else if (col == NZ) { *(f32x4*)(Gp + (size_t)row * 8) = a; *(f32x4*)(Gp + (size_t)row * 8 + 4) = b; } } };
__device__ __forceinline__ f32x4 ld4_res(const float* p) { return __builtin_nontemporal_load((const f32x4*)p); }
__device__ __forceinline__ f32x4 ld4_res(const bf16_t* p) { const u32x2 w = *(const u32x2*)p; return (f32x4){bflo(w.x), bfhi(w.x), bflo(w.y), bfhi(w.y)}; }
template <class BT> struct FResNorm { const BT* base; int brow0; bf16_t* out; bf16_t* xn; const float* g; float* ssq;
    __device__ __forceinline__ float rowscale(int) const { return 1.f; }
    __device__ __forceinline__ void operator()(int row, int col, f32x4 v) const {
        const f32x4 x = ld4_res(base + (size_t)(row - brow0) * D + col) + v;
        u32x2 o; o.x = pk2(x[0], x[1]); o.y = pk2(x[2], x[3]); *(u32x2*)(out + (size_t)row * D + col) = o;
        const f32x4 gg = *(const f32x4*)(g + col); u32x2 w; w.x = pk2(x[0] * gg[0], x[1] * gg[1]); w.y = pk2(x[2] * gg[2], x[3] * gg[3]); *(u32x2*)(xn + (size_t)row * D + col) = w;
        atomicAdd(ssq + row, (x[0] * x[0] + x[1] * x[1]) + (x[2] * x[2] + x[3] * x[3])); } };
template <class BT> struct EpiResNorm { static constexpr bool PERM = true; const BT* base; bf16_t* out; bf16_t* xn; const float* g; float* ssq;
    __device__ __forceinline__ void operator()(const f32x4 (&acc)[2][2][4][2], const pg8::Unit& u, int wr, int wc, int fr, int fq) const {
        f32x4 gg[2][2];
#pragma unroll
        for (int bj = 0; bj < 2; ++bj) { const int col = u.pn * 256 + bj * 128 + wc * 32 + 8 * fq; gg[bj][0] = *(const f32x4*)(g + col); gg[bj][1] = *(const f32x4*)(g + col + 4); }
#pragma unroll
        for (int ai = 0; ai < 2; ++ai)
#pragma unroll
            for (int m = 0; m < 4; ++m) {
                const int row = u.pm * 256 + ai * 128 + wr * 64 + m * 16 + fr; float ss = 0.f;
#pragma unroll
                for (int bj = 0; bj < 2; ++bj) { const size_t o = (size_t)row * D + u.pn * 256 + bj * 128 + wc * 32 + 8 * fq;
                    const f32x4 x0 = ld4_res(base + o) + acc[ai][bj][m][0], x1 = ld4_res(base + o + 4) + acc[ai][bj][m][1];
                    u32x4 w; w.x = pk2(x0[0], x0[1]); w.y = pk2(x0[2], x0[3]); w.z = pk2(x1[0], x1[1]); w.w = pk2(x1[2], x1[3]); *(u32x4*)(out + o) = w;
                    const f32x4 y0 = x0 * gg[bj][0], y1 = x1 * gg[bj][1];
                    u32x4 z; z.x = pk2(y0[0], y0[1]); z.y = pk2(y0[2], y0[3]); z.z = pk2(y1[0], y1[1]); z.w = pk2(y1[2], y1[3]); *(u32x4*)(xn + o) = z;
                    ss += ((x0[0] * x0[0] + x0[1] * x0[1]) + (x0[2] * x0[2] + x0[3] * x0[3])) + ((x1[0] * x1[0] + x1[1] * x1[1]) + (x1[2] * x1[2] + x1[3] * x1[3])); }
                ss += __shfl_xor(ss, 16); ss += __shfl_xor(ss, 32);
                if (fq == 0) atomicAdd(ssq + row, ss);
                if (m & 1) asm volatile("" ::: "memory");
            }
    } };
struct FResB { const bf16_t* base; bf16_t* out;
    __device__ __forceinline__ float rowscale(int) const { return 1.f; }
    __device__ __forceinline__ void f8(int row, int col, f32x4 a, f32x4 b) const {
        const size_t o = (size_t)row * D + col; const f32x4 x0 = ld4_res(base + o) + a, x1 = ld4_res(base + o + 4) + b;
        u32x4 w; w.x = pk2(x0[0], x0[1]); w.y = pk2(x0[2], x0[3]); w.z = pk2(x1[0], x1[1]); w.w = pk2(x1[2], x1[3]); *(u32x4*)(out + o) = w; } };
struct EpiSoftmax { static constexpr bool PERM = true; bf16_t* P; LAS float* xch;
    __device__ __forceinline__ void operator()(f32x4 (&acc)[2][2][4][2], const pg8::Unit& u, int wr, int wc, int fr, int fq) const {
        float mx[2][4];
#pragma unroll
        for (int ai = 0; ai < 2; ++ai)
#pragma unroll
            for (int m = 0; m < 4; ++m) {
                float v = -INFINITY;
#pragma unroll
                for (int bj = 0; bj < 2; ++bj)
#pragma unroll
                    for (int n = 0; n < 2; ++n) v = fmaxf(v, fmaxf(fmaxf(acc[ai][bj][m][n][0], acc[ai][bj][m][n][1]), fmaxf(acc[ai][bj][m][n][2], acc[ai][bj][m][n][3])));
                v = fmaxf(v, __shfl_xor(v, 16)); v = fmaxf(v, __shfl_xor(v, 32));
                if (fq == 0) xch[(ai * 128 + wr * 64 + m * 16 + fr) * 4 + wc] = v;
            }
        asm volatile("s_waitcnt lgkmcnt(0)" ::: "memory"); __builtin_amdgcn_s_barrier(); asm volatile("" ::: "memory");
#pragma unroll
        for (int ai = 0; ai < 2; ++ai)
#pragma unroll
            for (int m = 0; m < 4; ++m) {
                const f32x4 t = *(const LAS f32x4*)(xch + (ai * 128 + wr * 64 + m * 16 + fr) * 4);
                mx[ai][m] = fmaxf(fmaxf(t[0], t[1]), fmaxf(t[2], t[3]));
                float s = 0.f;
#pragma unroll
                for (int bj = 0; bj < 2; ++bj)
#pragma unroll
                    for (int n = 0; n < 2; ++n)
#pragma unroll
                        for (int e = 0; e < 4; ++e) { const float p = __expf(acc[ai][bj][m][n][e] - mx[ai][m]); acc[ai][bj][m][n][e] = p; s += p; }
                s += __shfl_xor(s, 16); s += __shfl_xor(s, 32);
                if (fq == 0) xch[1024 + (ai * 128 + wr * 64 + m * 16 + fr) * 4 + wc] = s;
            }
        asm volatile("s_waitcnt lgkmcnt(0)" ::: "memory"); __builtin_amdgcn_s_barrier(); asm volatile("" ::: "memory");
#pragma unroll
        for (int ai = 0; ai < 2; ++ai)
#pragma unroll
            for (int m = 0; m < 4; ++m) {
                const f32x4 t = *(const LAS f32x4*)(xch + 1024 + (ai * 128 + wr * 64 + m * 16 + fr) * 4);
                const float inv = 1.f / ((t[0] + t[1]) + (t[2] + t[3]));
                const int row = u.pm * 256 + ai * 128 + wr * 64 + m * 16 + fr;
#pragma unroll
                for (int bj = 0; bj < 2; ++bj) { const f32x4 a = acc[ai][bj][m][0] * inv, b = acc[ai][bj][m][1] * inv;
                    u32x4 w; w.x = pk2(a[0], a[1]); w.y = pk2(a[2], a[3]); w.z = pk2(b[0], b[1]); w.w = pk2(b[2], b[3]);
                    *(u32x4*)(P + (size_t)row * 1024 + u.pn * 256 + bj * 128 + wc * 32 + 8 * fq) = w; }
            }
    } };
struct FVw { bf16_t* VWt;
    __device__ __forceinline__ float rowscale(int) const { return 1.f; }
    __device__ __forceinline__ void f8(int row, int col, f32x4 a, f32x4 b) const {
        const int bb = col >> 10, hk = col & 1023; u32x4 w; w.x = pk2(a[0], a[1]); w.y = pk2(a[2], a[3]); w.z = pk2(b[0], b[1]); w.w = pk2(b[2], b[3]);
        *(u32x4*)(VWt + ((size_t)bb * D + row) * 1024 + hk) = w; } };
struct FQkSplit { bf16_t* Qm; size_t kdelta;
    __device__ __forceinline__ float rowscale(int) const { return 1.f; }
    __device__ __forceinline__ void operator()(int row, int col, f32x4 v) const {
        const int h = col >> 9, j = col & 511; bf16_t* dst = Qm + (size_t)(j >> 8) * kdelta + (size_t)row * 1024 + h * 256 + (j & 255);
        u32x2 w; w.x = pk2(v[0], v[1]); w.y = pk2(v[2], v[3]); *(u32x2*)dst = w; }
    __device__ __forceinline__ void f8(int row, int col, f32x4 a, f32x4 b) const {
        const int h = col >> 9, j = col & 511; bf16_t* dst = Qm + (size_t)(j >> 8) * kdelta + (size_t)row * 1024 + h * 256 + (j & 255);
        u32x4 w; w.x = pk2(a[0], a[1]); w.y = pk2(a[2], a[3]); w.z = pk2(b[0], b[1]); w.w = pk2(b[2], b[3]); *(u32x4*)dst = w; } };
struct FMk { bf16_t* MK; float* out;
    __device__ __forceinline__ float rowscale(int) const { return 1.f; }
    __device__ __forceinline__ void operator()(int row, int col, f32x4 v) const {
        u32x2 w; w.x = pk2(v[0], v[1]); w.y = pk2(v[2], v[3]); *(u32x2*)(MK + (size_t)row * D + col) = w; __builtin_nontemporal_store(v, (f32x4*)(out + (size_t)row * D + col)); } };
struct FMvt { bf16_t* MVt; float* out;
    __device__ __forceinline__ float rowscale(int) const { return 1.f; }
    __device__ __forceinline__ void operator()(int row, int col, f32x4 v) const {
        u32x2 w; w.x = pk2(v[0], v[1]); w.y = pk2(v[2], v[3]); *(u32x2*)(MVt + ((size_t)(col >> 8) * D + row) * 256 + (col & 255)) = w;
#pragma unroll
        for (int e = 0; e < 4; ++e) out[(size_t)(col + e) * D + row] = v[e]; } };
struct FPart { float* P; int ld;
    __device__ __forceinline__ float rowscale(int) const { return 1.f; }
    __device__ __forceinline__ void operator()(int row, int col, f32x4 v) const { *(f32x4*)(P + (size_t)row * ld + col) = v; } };
struct FRi { bf16_t* R; size_t plane;
    __device__ __forceinline__ float rowscale(int) const { return 1.f; }
    __device__ __forceinline__ void operator()(int row, int col, f32x4 v) const {
        const int h = col >> 8, isI = (col >> 7) & 1, ch = h * 128 + (col & 127); u32x2 w; w.x = pk2(v[0], v[1]); w.y = pk2(v[2], v[3]); *(u32x2*)(R + (size_t)isI * plane + (size_t)row * 1024 + ch) = w; }
    __device__ __forceinline__ void f8(int row, int col, f32x4 a, f32x4 b) const {
        const int h = col >> 8, isI = (col >> 7) & 1, ch = h * 128 + (col & 127); u32x4 w; w.x = pk2(a[0], a[1]); w.y = pk2(a[2], a[3]); w.z = pk2(b[0], b[1]); w.w = pk2(b[2], b[3]);
        *(u32x4*)(R + (size_t)isI * plane + (size_t)row * 1024 + ch) = w; } };
__device__ __forceinline__ f32x2 gate_one(float rp, float ip, float ba, float bx, float sp, float xc) {
    const float r = sigmoidf_(rp + ba), i = sigmoidf_(ip + bx);
    const float la = -8.f * r * sp;
    const float a = __expf(la);
    return (f32x2){a, sqrtf(fmaxf(1.f - a * a, 0.f)) * (i * xc)};
}
template <class G>
__device__ __forceinline__ void skinny_piece(const bf16_t* A, int lda, const bf16_t* Bt, int ldb, int Kc, int ncol0, int row0, const G& g, const int w, LAS float* red) {
    const int lane = lane_id(), fr = lane & 15, fq = lane >> 4;
    const int kw = Kc >> 3, wk = (w + (int)blockIdx.x) & 7;
    f32x4 acc[8][2];
#pragma unroll
    for (int r = 0; r < 8; ++r) { acc[r][0] = (f32x4){0.f, 0.f, 0.f, 0.f}; acc[r][1] = (f32x4){0.f, 0.f, 0.f, 0.f}; }
    const bf16_t* ap = A + (size_t)fr * lda + wk * kw + 8 * fq;
    const bf16_t* bp = Bt + (size_t)(ncol0 + fr) * ldb + wk * kw + 8 * fq;
#pragma unroll 4
    for (int k = 0; k < kw; k += 32) {
        const bf16x8 b0 = ld8(bp + k), b1 = ld8(bp + (size_t)16 * ldb + k);
#pragma unroll
        for (int r = 0; r < 8; ++r) { const bf16x8 a = ld8(ap + (size_t)(16 * r) * lda + k); acc[r][0] = MFMA16(b0, a, acc[r][0]); acc[r][1] = MFMA16(b1, a, acc[r][1]); }
    }
    __syncthreads();
#pragma unroll
    for (int r = 0; r < 8; ++r)
#pragma unroll
        for (int t = 0; t < 2; ++t) *(LAS f32x4*)(red + ((w * 16 + r * 2 + t) * 64 + lane) * 4) = acc[r][t];
    __syncthreads();
#pragma unroll
    for (int t = 0; t < 2; ++t) {
        f32x4 s = (f32x4){0.f, 0.f, 0.f, 0.f};
#pragma unroll
        for (int ww = 0; ww < 8; ++ww) s = s + *(const LAS f32x4*)(red + ((ww * 16 + w * 2 + t) * 64 + lane) * 4);
        g(row0 + 16 * w + fr, ncol0 + 16 * t + 4 * fq, s * g.rowscale(row0 + 16 * w + fr));
    }
}
template <class G>
__device__ __forceinline__ void skinny_gemm(const bf16_t* A, int lda, const bf16_t* Bt, int ldb, int K, int N, int ksplit, int cu0, int ncu, int row0, const G& g, int part_rows, const int w, LAS float* red) {
    const int me = (int)blockIdx.x - cu0; if (me < 0 || me >= ncu) return;
    const int nsl = N / 32, np = nsl * ksplit, Kc = K / ksplit;
    for (int p = me; p < np; p += ncu) {
        const int sl = p % nsl, ks = p / nsl;
        skinny_piece(A + (size_t)ks * Kc, lda, Bt + (size_t)ks * Kc, ldb, Kc, 32 * sl, row0 + ks * part_rows, g, w, red);
    }
}
#define XB_TMO      128
#define XB_XCNT(j)  (256  + 64 * (j))
#define XB_XSUB(j)  (1280 + 64 * (j))
#define XB_XGEN(j)  (2304 + 64 * (j))
#define XB_TOP      3328
#define XB_TOPGEN   3392
#define XCD_BAR_WORDS 3456
#define XB_SPIN_CAP (1u << 18)
__device__ __forceinline__ unsigned xb_ld(unsigned* p)              { return __hip_atomic_load(p, __ATOMIC_RELAXED, __HIP_MEMORY_SCOPE_AGENT); }
__device__ __forceinline__ unsigned xb_add(unsigned* p, unsigned v) { return __hip_atomic_fetch_add(p, v, __ATOMIC_RELAXED, __HIP_MEMORY_SCOPE_AGENT); }
__device__ __forceinline__ unsigned xb_xcc_id() { return (unsigned)__builtin_amdgcn_s_getreg((3 << 11) | 20) & 0xFu; }
#define XB_SPIN(cond, bar) do { unsigned _sp = 0; while (cond) { __builtin_amdgcn_s_sleep(1); \
    if ((++_sp & 255u) == 0u) { if (xb_ld(&(bar)[XB_TMO])) break; if (_sp > XB_SPIN_CAP) { atomicAdd(&(bar)[XB_TMO], 1u); break; } } } } while (0)
struct XcdBarrier { unsigned* bar; unsigned x; volatile LAS unsigned* st; };
__device__ __forceinline__ void xcd_barrier_complete(unsigned* bar, unsigned x, unsigned& nloc, unsigned& nx) {
    const unsigned G = gridDim.x * gridDim.y * gridDim.z;
    unsigned sum, cnt, mine, sp = 0u;
    for (;;) {
        sum = 0u; cnt = 0u; mine = 0u;
#pragma unroll
        for (unsigned j = 0; j < 16; ++j) { const unsigned c = xb_ld(&bar[XB_XCNT(j)]); sum += c; cnt += (c > 0u) ? 1u : 0u; mine = (j == x) ? c : mine; }
        if (sum == G) break;
        __builtin_amdgcn_s_sleep(1);
        if ((++sp & 255u) == 0u) { if (xb_ld(&bar[XB_TMO])) break; if (sp > XB_SPIN_CAP) { atomicAdd(&bar[XB_TMO], 1u); break; } }
    }
    nloc = mine > 0u ? mine : 1u; nx = cnt > 0u ? cnt : 1u;
}
__device__ __forceinline__ void xcd_barrier(const XcdBarrier& b, const int wave) {
    asm volatile("s_waitcnt vmcnt(0)" ::: "memory");
    __syncthreads();
    if (wave == 0 && lane_id() == 0) {
        unsigned* bar = b.bar;
        __builtin_amdgcn_s_waitcnt(0);
        unsigned nloc = b.st[0], nx = b.st[1];
        if (nloc == 0u) { xcd_barrier_complete(bar, b.x, nloc, nx); b.st[0] = nloc; b.st[1] = nx; }
        const unsigned old = xb_add(&bar[XB_XSUB(b.x)], 1u);
        const unsigned gen = old / nloc;
        if (old + 1u == (gen + 1u) * nloc) {
            __builtin_amdgcn_fence(__ATOMIC_RELEASE, "agent");
            asm volatile("s_waitcnt vmcnt(0)" ::: "memory");
            const unsigned og = xb_add(&bar[XB_TOP], 1u);
            const unsigned tg = og / nx;
            if (og + 1u == (tg + 1u) * nx) xb_add(&bar[XB_TOPGEN], 1u);
            else XB_SPIN(xb_ld(&bar[XB_TOPGEN]) == tg, bar);
            __builtin_amdgcn_fence(__ATOMIC_ACQUIRE, "agent");
            xb_add(&bar[XB_XGEN(b.x)], 1u);
            asm volatile("s_waitcnt vmcnt(0)" ::: "memory");
        } else {
            XB_SPIN(xb_ld(&bar[XB_XGEN(b.x)]) == gen, bar);
            __builtin_amdgcn_fence(__ATOMIC_ACQUIRE, "agent");
            asm volatile("s_waitcnt vmcnt(0)" ::: "memory");
        }
    }
    __syncthreads();
}

struct Args { const float* in[39]; float* out; unsigned char* ws; int ph_lo, ph_hi; };
enum { I_XP = 0, I_XS, I_MEM, I_SRH, I_SRC, I_SMC_, I_SMN, I_SMM, I_SMCV, I_CK, I_CV, I_GMIX, I_WIN, I_CRW, I_CRB, I_WA, I_BA, I_WX, I_BX, I_LAM, I_GRNN,
       I_CMW, I_CMB, I_WQ, I_WK, I_BI, I_BF, I_GML, I_WOUT, I_GX, I_GMEM, I_WCQ, I_WMK, I_WMV, I_WCO, I_GFFN, I_WUP, I_WDN, I_GFIN };

__device__ __forceinline__ void transpose_item(const float* W, int ldw, bf16_t* WT, int ldt, LAS float* scr, int kb, int nb, int lane) {
    const int k0 = 64 * kb, n0 = 32 * nb;
    f32x4 ld[8];
#pragma unroll
    for (int i = 0; i < 8; ++i) ld[i] = __builtin_nontemporal_load((const f32x4*)(W + (size_t)(k0 + 8 * i + (lane >> 3)) * ldw + n0 + 4 * (lane & 7)));
#pragma unroll
    for (int i = 0; i < 8; ++i) { LAS float* d = scr + (8 * i + (lane >> 3)) * 33 + 4 * (lane & 7); d[0] = ld[i][0]; d[1] = ld[i][1]; d[2] = ld[i][2]; d[3] = ld[i][3]; }
    asm volatile("s_waitcnt lgkmcnt(0)" ::: "memory");
    const int c = lane & 7;
#pragma unroll
    for (int j = 0; j < 4; ++j) { const int n = (lane >> 3) + 8 * j; const LAS float* s = scr + (8 * c) * 33 + n;
        u32x4 o; o.x = pk2(s[0 * 33], s[1 * 33]); o.y = pk2(s[2 * 33], s[3 * 33]); o.z = pk2(s[4 * 33], s[5 * 33]); o.w = pk2(s[6 * 33], s[7 * 33]);
        *(u32x4*)(WT + (size_t)(n0 + n) * ldt + k0 + 8 * c) = o; }
    asm volatile("s_waitcnt lgkmcnt(0)" ::: "memory");
}
__device__ __forceinline__ void convert_matrix(const float* W, int ldw, int K, int N, bf16_t* WT, int ldt, LAS float* scr, int gw_, int ngw_, int lane) {
    const int nb = N / 32, items = (K / 64) * nb;
    for (int it = gw_; it < items; it += ngw_) transpose_item(W, ldw, WT, ldt, scr, it / nb, it % nb, lane);
}
__device__ __forceinline__ void load_gain(const float* g, int lane, f32x4 (&gg)[8]) {
#pragma unroll
    for (int j = 0; j < 8; ++j) gg[j] = *(const f32x4*)(g + 256 * j + 4 * lane);
}
__device__ __forceinline__ void norm_row(const float* xrow, const f32x4 (&gg)[8], bf16_t* orow, int lane) {
    f32x4 v[8]; float ss = 0.f;
#pragma unroll
    for (int j = 0; j < 8; ++j) { v[j] = __builtin_nontemporal_load((const f32x4*)(xrow + 256 * j + 4 * lane)); ss += (v[j][0] * v[j][0] + v[j][1] * v[j][1]) + (v[j][2] * v[j][2] + v[j][3] * v[j][3]); }
    const float rstd = rsqrtf(wave_sum(ss) * (1.f / D) + EPS);
#pragma unroll
    for (int j = 0; j < 8; ++j) { const f32x4 a = v[j] * rstd * gg[j]; u32x2 w; w.x = pk2(a[0], a[1]); w.y = pk2(a[2], a[3]); *(u32x2*)(orow + 256 * j + 4 * lane) = w; }
}

#define wsWinT ((bf16_t*)(ws + WS_WIN2))
#define wsWoutT ((bf16_t*)(ws + WS_WOUT))
#define wsWcqT ((bf16_t*)(ws + WS_WCQ))
#define wsWmkT ((bf16_t*)(ws + WS_WMK))
#define wsWmvT ((bf16_t*)(ws + WS_WMV))
#define wsWcoT ((bf16_t*)(ws + WS_WCO))
#define wsWupT ((bf16_t*)(ws + WS_WUP))
#define wsWdnT ((bf16_t*)(ws + WS_WDN))
#define wsWgT ((bf16_t*)(ws + WS_WG))
#define wsWqkT ((bf16_t*)(ws + WS_WQK))
#define wsXN ((bf16_t*)(ws + WS_XN))
#define wsMN ((bf16_t*)(ws + WS_MN))
#define wsZ ((bf16_t*)(ws + WS_Z))
#define wsGATES ((float*)(ws + WS_GATES))
#define wsXC ((bf16_t*)(ws + WS_XC))
#define wsUC ((bf16_t*)(ws + WS_UC))
#define wsAU ((bf16_t*)(ws + WS_AU))
#define wsQm ((bf16_t*)(ws + WS_QM))
#define wsKm ((bf16_t*)(ws + WS_KM))
#define wsY ((bf16_t*)(ws + WS_Y))
#define wsX1 ((bf16_t*)(ws + WS_X1))
#define wsX2 ((bf16_t*)(ws + WS_X2))
#define wsQC ((bf16_t*)(ws + WS_QC))
#define wsOC ((bf16_t*)(ws + WS_OC))
#define wsMK ((bf16_t*)(ws + WS_MK))
#define wsMVt ((bf16_t*)(ws + WS_MVT))
#define wsVW ((bf16_t*)(ws + WS_Y))
#define wsU ((bf16_t*)(ws + WS_U))
#define wsCLOC ((bf16_t*)(ws + WS_CLOC))
#define wsCIN ((bf16_t*)(ws + WS_CIN))
#define wsNLOC ((float*)(ws + WS_NLOC))
#define wsNIN ((float*)(ws + WS_NIN))
#define wsMSTAT ((float*)(ws + WS_MSTAT))
#define wsMINB (wsMSTAT + 1024)
#define wsSUM ((float*)(ws + WS_SUM))
#define wsPART ((float*)(ws + WS_PART))
#define wsSPL (wsMSTAT + 4096)
#define wsSS (wsMSTAT + 8192)
#define wsPB ((bf16_t*)(ws + WS_U))
__global__ void __launch_bounds__(512, 2) mega_fwd(Args args) {
    extern __shared__ __attribute__((aligned(16))) unsigned char lds_raw[];
    LAS unsigned char* lds = (LAS unsigned char*)lds_raw;
    LAS float* misc = (LAS float*)(lds + MISC_OFF);
    const int wave = __builtin_amdgcn_readfirstlane((int)threadIdx.x >> 6);
    const int G = gridDim.x, bid = blockIdx.x;
    const int NGW = G * 8, NGT = G * 512;
#define PH_IDS const int lane = lane_id(); const int tid = wave * 64 + lane; const int gw = bid * 8 + wave; const int gt = bid * 512 + tid; (void)gw; (void)gt; (void)lane; (void)tid;
    unsigned char* ws = args.ws;
    float* out = args.out;
    volatile LAS unsigned* bst = (volatile LAS unsigned*)(lds + LDS_BYTES - 16);
    if (wave == 0 && lane_id() == 0) { bst[0] = 0u; bst[1] = 0u; }
    __syncthreads();
    XcdBarrier xbar; xbar.bar = (unsigned*)(ws + WS_CTL); xbar.x = xb_xcc_id(); xbar.st = bst;
    if (wave == 0 && lane_id() == 0) (void)xb_add(&xbar.bar[XB_XCNT(xbar.x)], 1u);
    const int lo = args.ph_lo, hi = args.ph_hi;
#ifndef PH_MASK
#define PH_MASK 0xFFFF
#endif
#define IN(k) (((PH_MASK >> (k)) & 1) && lo <= (k) && (k) < hi)
#ifndef DUP_MASK
#define DUP_MASK 0
#endif
#define REP(k) for (int rep_ = 0; rep_ <= ((DUP_MASK >> (k)) & 1); ++rep_)
#ifndef DUP_BAR
#define DUP_BAR 0
#endif
#define SEAM(k) do { if (IN(k)) { xcd_barrier(xbar, wave); if (DUP_BAR) { xcd_barrier(xbar, wave); xcd_barrier(xbar, wave); } } } while (0)

    REP(0) if (IN(0)) { PH_IDS
        LAS float* scr = (LAS float*)(lds + wave * 16384);
        constexpr int I_A = 32 * 160, I_S = 32 * 64, NIT = I_A + 3 * I_S;
        for (int it = gw; it < NIT; it += NGW) {
            int r = it;
            if (r < I_A) { transpose_item(args.in[I_WIN], DIN, wsWinT, D, scr, r / 160, r % 160, lane); continue; } r -= I_A;
            if (r < I_S) { transpose_item(args.in[I_WOUT], D, wsWoutT, D, scr, r / 64, r % 64, lane); continue; } r -= I_S;
            if (r < I_S) { transpose_item(args.in[I_WMK], D, wsWmkT, D, scr, r / 64, r % 64, lane); continue; } r -= I_S;
            transpose_item(args.in[I_WMV], D, wsWmvT, D, scr, r / 64, r % 64, lane);
        }
        for (int idx = gt; idx < 8 * 256 * 256; idx += NGT) {
            const int h = idx >> 16, j = (idx >> 8) & 255, k = idx & 255, kk = k - (h & 1) * 128;
            float v = 0.f;
            if (kk >= 0 && kk < 128) v = (j < 128) ? args.in[I_WA][((size_t)h * 128 + kk) * 128 + j] : args.in[I_WX][((size_t)h * 128 + kk) * 128 + (j - 128)];
            wsWgT[idx] = (bf16_t)f2bf(v);
        }
        for (int idx = gt; idx < 4 * 512 * 256; idx += NGT) {
            const int h = idx >> 17, j = (idx >> 8) & 511, k = idx & 255;
            const float v = (j < 256) ? args.in[I_WQ][((size_t)h * 256 + k) * 256 + j] : args.in[I_WK][((size_t)h * 256 + k) * 256 + (j - 256)] * 0.0625f;
            wsWqkT[idx] = (bf16_t)f2bf(v);
        }
        for (int idx = gt; idx < 2 * MT; idx += NGT) wsSS[idx] = 0.f;
        for (int idx = gt; idx < 1024; idx += NGT) { const float l = args.in[I_LAM][idx]; wsSPL[idx] = fmaxf(-l, 0.f) + log1pf(__expf(-fabsf(l))); }
        for (int idx = gt; idx < 8 * 2048; idx += NGT) { const int c = idx >> 11, k = idx & 2047; wsWinT[(size_t)(NZ + c) * D + k] = (bf16_t)f2bf(args.in[I_WIN][(size_t)k * DIN + NZ + c]); }
        { f32x4 gg[8]; load_gain(args.in[I_GMIX], lane, gg);
          for (int m = gw; m < MT; m += NGW) { const float* xrow = m < MP ? args.in[I_XP] + (size_t)m * D : args.in[I_XS] + (size_t)(m - MP) * D; norm_row(xrow, gg, wsXN + (size_t)m * D, lane); } }
        { f32x4 gg[8]; load_gain(args.in[I_GMEM], lane, gg);
          for (int m = gw; m < MMEM; m += NGW) norm_row(args.in[I_MEM] + (size_t)m * D, gg, wsMN + (size_t)m * D, lane); }
        __syncthreads();
    }
    SEAM(0);

    REP(1) if (IN(1)) { PH_IDS
        { const pg8::Gemm g = pg8::mk_gemm(wsXN, wsWinT, D * 2, D * 2, D, 0); pg8::StaticOrder S; S.init(33, 21, G, bid);
          pg8::EpiF8<FZ> E{{wsZ, wsGATES}}; pg8::gemm_phase<pg8::EpiF8<FZ>, true, true>(lds, g, S, E, wave); }
        { const pg8::Gemm g = pg8::mk_gemm(wsMN, wsWmkT, D * 2, D * 2, D, 0); pg8::StaticOrder S; S.init(4, 8, G, G - 1 - bid);
          pg8::EpiF<FMk> E{{wsMK, out + O_PK}}; pg8::gemm_phase<pg8::EpiF<FMk>, true, true>(lds, g, S, E, wave); }
        { const pg8::Gemm g = pg8::mk_gemm(wsMN, wsWmvT, D * 2, D * 2, D, 0); pg8::StaticOrder S; S.init(4, 8, G, G - 33 - bid);
          pg8::EpiF<FMk> E{{wsMVt, out + O_PV}}; pg8::gemm_phase<pg8::EpiF<FMk>, true, true>(lds, g, S, E, wave); }
    }
    SEAM(1);

    REP(2) if (IN(2)) { PH_IDS
        const int gi = gt & 255, which = gi >> 7, c0 = (gi & 127) * 8, zc = (which ? OFF_MU : OFF_RX) + c0;
        const float* cw = args.in[which ? I_CMW : I_CRW]; const float* cb = args.in[which ? I_CMB : I_CRB];
        float wt[4][8], wb[8];
#pragma unroll
        for (int e = 0; e < 8; ++e) { wb[e] = cb[c0 + e];
#pragma unroll
            for (int j = 0; j < 4; ++j) wt[j][e] = cw[j * 1024 + c0 + e]; }
        for (int gq = gt >> 8; gq < MP / 4; gq += NGT >> 8) {
            const int m0 = 4 * gq, t0 = m0 & (TT - 1);
            float x[7][8];
#pragma unroll
            for (int k = 0; k < 7; ++k) {
                if (t0 - 3 + k >= 0) { const u32x4 w = *(const u32x4*)(wsZ + (size_t)(m0 - 3 + k) * NZ + zc);
                    x[k][0] = bflo(w.x); x[k][1] = bfhi(w.x); x[k][2] = bflo(w.y); x[k][3] = bfhi(w.y); x[k][4] = bflo(w.z); x[k][5] = bfhi(w.z); x[k][6] = bflo(w.w); x[k][7] = bfhi(w.w); }
                else {
#pragma unroll
                    for (int e = 0; e < 8; ++e) x[k][e] = 0.f; }
            }
            if (t0 == TT - 4) { float* o = out + (which ? O_PMC : O_PRC) + (size_t)(m0 >> 11) * 3 * 1024 + c0;
#pragma unroll
                for (int i = 0; i < 3; ++i) { *(f32x4*)(o + i * 1024) = (f32x4){x[4 + i][0], x[4 + i][1], x[4 + i][2], x[4 + i][3]}; *(f32x4*)(o + i * 1024 + 4) = (f32x4){x[4 + i][4], x[4 + i][5], x[4 + i][6], x[4 + i][7]}; } }
#pragma unroll
            for (int r = 0; r < 4; ++r) {
                float y[8];
#pragma unroll
                for (int e = 0; e < 8; ++e) y[e] = wb[e];
#pragma unroll
                for (int j = 0; j < 4; ++j)
#pragma unroll
                    for (int e = 0; e < 8; ++e) y[e] += wt[j][e] * x[r + j][e];
                if (which) {
#pragma unroll
                    for (int e = 0; e < 8; ++e) y[e] = y[e] * sigmoidf_(y[e]);
                }
                u32x4 w; w.x = pk2(y[0], y[1]); w.y = pk2(y[2], y[3]); w.z = pk2(y[4], y[5]); w.w = pk2(y[6], y[7]);
                *(u32x4*)((which ? wsUC : wsXC) + (size_t)(m0 + r) * 1024 + c0) = w;
            }
        }
        for (int m = MP + (gt >> 8); m < MT; m += NGT >> 8) {
            float x[4][8];
            {
                const int sb = m - MP; const float* st = args.in[which ? I_SMCV : I_SRC] + (size_t)sb * 3 * 1024 + c0;
#pragma unroll
                for (int j = 0; j < 3; ++j) { const f32x4 a = *(const f32x4*)(st + j * 1024), b = *(const f32x4*)(st + j * 1024 + 4);
                    x[j][0] = a[0]; x[j][1] = a[1]; x[j][2] = a[2]; x[j][3] = a[3]; x[j][4] = b[0]; x[j][5] = b[1]; x[j][6] = b[2]; x[j][7] = b[3]; }
                const u32x4 w = *(const u32x4*)(wsZ + (size_t)m * NZ + zc);
                x[3][0] = bflo(w.x); x[3][1] = bfhi(w.x); x[3][2] = bflo(w.y); x[3][3] = bfhi(w.y); x[3][4] = bflo(w.z); x[3][5] = bfhi(w.z); x[3][6] = bflo(w.w); x[3][7] = bfhi(w.w);
                float* o = out + (which ? O_SMC : O_SRC) + (size_t)sb * 3 * 1024 + c0;
#pragma unroll
                for (int j = 0; j < 3; ++j) { *(f32x4*)(o + j * 1024) = (f32x4){x[j + 1][0], x[j + 1][1], x[j + 1][2], x[j + 1][3]}; *(f32x4*)(o + j * 1024 + 4) = (f32x4){x[j + 1][4], x[j + 1][5], x[j + 1][6], x[j + 1][7]}; }
            }
            float y[8];
#pragma unroll
            for (int e = 0; e < 8; ++e) y[e] = wb[e];
#pragma unroll
            for (int j = 0; j < 4; ++j)
#pragma unroll
                for (int e = 0; e < 8; ++e) y[e] += wt[j][e] * x[j][e];
            if (which) {
#pragma unroll
                for (int e = 0; e < 8; ++e) y[e] = y[e] * sigmoidf_(y[e]);
            }
            u32x4 w; w.x = pk2(y[0], y[1]); w.y = pk2(y[2], y[3]); w.z = pk2(y[4], y[5]); w.w = pk2(y[6], y[7]);
            *(u32x4*)((which ? wsUC : wsXC) + (size_t)m * 1024 + c0) = w;
        }
    }
    SEAM(2);

    REP(3) if (IN(3)) { PH_IDS
        { const pg8::Gemm g = pg8::mk_gemm(wsXC, wsWgT, 2048, 512, 256, 512); pg8::StaticOrder S; S.init(32, 8, G, bid);
          pg8::EpiF8<FRi> E{{wsAU, (size_t)MT * 1024}}; pg8::gemm_phase<pg8::EpiF8<FRi>, true, true>(lds, g, S, E, wave); }
        { const pg8::Gemm g = pg8::mk_gemm(wsUC, wsWqkT, 2048, 512, 256, 512); pg8::StaticOrder S; S.init(32, 8, G, bid);
          pg8::EpiF8<FQkSplit> E{{wsQm, (WS_KM - WS_QM) / 2}}; pg8::gemm_phase<pg8::EpiF8<FQkSplit>, true, true>(lds, g, S, E, wave); }
        if (bid < 64) { const int h = bid >> 3;
            skinny_piece(wsXC + (size_t)MP * 1024 + 256 * (h >> 1), 1024, wsWgT, 256, 256, 32 * bid, MP, FRi{wsAU, (size_t)MT * 1024}, wave, (LAS float*)lds); }
        else if (bid < 128) { const int p = bid - 64; const int hh = p >> 4;
            skinny_piece(wsUC + (size_t)MP * 1024 + 256 * hh, 1024, wsWqkT, 256, 256, 32 * p, MP, FQkSplit{wsQm, (WS_KM - WS_QM) / 2}, wave, (LAS float*)lds); }
    }
    SEAM(3);

    REP(4) if (IN(4)) { PH_IDS
        for (int u = bid; u < 256; u += G) {
            const int m0 = (u >> 6) * TT + (u & 63) * 32;
            float A0 = 1.f, A1 = 1.f, h0 = 0.f, h1 = 0.f;
            const f32x2 ba = *(const f32x2*)(args.in[I_BA] + 2 * tid), bx = *(const f32x2*)(args.in[I_BX] + 2 * tid), sp = *(const f32x2*)(wsSPL + 2 * tid);
#pragma unroll 8
            for (int i = 0; i < 32; ++i) { const size_t o = (size_t)(m0 + i) * 1024 + 2 * tid;
                const unsigned rw_ = *(const unsigned*)(wsAU + o), iw_ = *(const unsigned*)(wsAU + (size_t)MT * 1024 + o); const f32x2 rp = (f32x2){bflo(rw_), bfhi(rw_)}, ip = (f32x2){bflo(iw_), bfhi(iw_)}; const unsigned xw = *(const unsigned*)(wsXC + o);
                const f32x2 g0 = gate_one(rp[0], ip[0], ba[0], bx[0], sp[0], bflo(xw)), g1 = gate_one(rp[1], ip[1], ba[1], bx[1], sp[1], bfhi(xw));
                h0 = g0[0] * h0 + g0[1]; A0 *= g0[0]; h1 = g1[0] * h1 + g1[1]; A1 *= g1[0]; }
            *(f32x4*)(wsSUM + ((size_t)u * 1024 + 2 * tid) * 2) = (f32x4){A0, h0, A1, h1};
        }
        for (int u = bid; u < 256; u += G) {
            const int bh = u >> 4, c = u & 15, b = bh >> 2, h = bh & 3, m0 = b * TT + c * 128;
            LAS float* ic = misc; LAS float* bb = misc + 128; LAS float* wv = misc + 256; LAS float* sc = misc + 384;
            __syncthreads();
            if (tid < 128) { ic[tid] = wsGATES[(size_t)(m0 + tid) * 8 + h] + args.in[I_BI][h]; bb[tid] = logsigmoid_(wsGATES[(size_t)(m0 + tid) * 8 + 4 + h] + args.in[I_BF][h]); }
            __syncthreads();
            if (wave == 0) {
                const float x0 = bb[2 * lane], x1 = bb[2 * lane + 1], loc = x0 + x1; float inc = loc;
#pragma unroll
                for (int o = 1; o < 64; o <<= 1) { const float t = __shfl_up(inc, o); if (lane >= o) inc += t; }
                const float b0 = inc - x1, b1 = inc, a = __shfl(inc, 63);
                const float mx = wave_max(fmaxf(ic[2 * lane] + a - b0, ic[2 * lane + 1] + a - b1));
                bb[2 * lane] = b0; bb[2 * lane + 1] = b1;
                if (lane == 0) { sc[0] = mx; sc[1] = a; wsMSTAT[u * 2] = mx; wsMSTAT[u * 2 + 1] = a; }
            }
            __syncthreads();
            if (tid < 128) wv[tid] = __expf(ic[tid] + sc[1] - bb[tid] - sc[0]);
            __syncthreads();
            LAS unsigned char* VTl = lds; LAS unsigned char* KTl = lds + 67584;
            for (int idx = tid; idx < 128 * 32; idx += 512) {
                const int s = idx >> 5, ch = idx & 31; const float w = wv[s];
                const u32x4 v = *(const u32x4*)(wsZ + (size_t)(m0 + s) * NZ + OFF_MV + h * 256 + ch * 8);
                u32x4 o; o.x = pk2(bflo(v.x) * w, bfhi(v.x) * w); o.y = pk2(bflo(v.y) * w, bfhi(v.y) * w); o.z = pk2(bflo(v.z) * w, bfhi(v.z) * w); o.w = pk2(bflo(v.w) * w, bfhi(v.w) * w);
                *(LAS u32x4*)(VTl + s * 528 + ch * 16) = o;
                *(LAS u32x4*)(KTl + s * 528 + ch * 16) = *(const u32x4*)(wsKm + (size_t)(m0 + s) * 1024 + h * 256 + ch * 8);
            }
            __syncthreads();
            {
                const int g4 = lane >> 4, q = (lane & 15) >> 2, p = lane & 3;
                f32x4 acc[2][16];
#pragma unroll
                for (int a = 0; a < 2; ++a)
#pragma unroll
                    for (int k = 0; k < 16; ++k) acc[a][k] = (f32x4){0.f, 0.f, 0.f, 0.f};
                for (int ks = 0; ks < 4; ++ks) {
                    const int rb = (32 * ks + 8 * g4 + q) * 528 + 8 * p;
                    bf16x8 yv[2];
#pragma unroll
                    for (int a = 0; a < 2; ++a) yv[a] = cat8(tr_read(VTl + rb + (32 * wave + 16 * a) * 2), tr_read(VTl + rb + 4 * 528 + (32 * wave + 16 * a) * 2));
#pragma unroll
                    for (int kt = 0; kt < 16; ++kt) {
                        const bf16x8 xk = cat8(tr_read(KTl + rb + 32 * kt), tr_read(KTl + rb + 4 * 528 + 32 * kt));
                        acc[0][kt] = MFMA16(xk, yv[0], acc[0][kt]); acc[1][kt] = MFMA16(xk, yv[1], acc[1][kt]);
                    }
                }
#pragma unroll
                for (int a = 0; a < 2; ++a)
#pragma unroll
                    for (int kt = 0; kt < 16; ++kt) { u32x2 w; w.x = pk2(acc[a][kt][0], acc[a][kt][1]); w.y = pk2(acc[a][kt][2], acc[a][kt][3]);
                        *(u32x2*)(wsCLOC + (size_t)u * 65536 + (size_t)(32 * wave + 16 * a + (lane & 15)) * 256 + 16 * kt + 4 * g4) = w; }
            }
            if (tid < 256) { float s = 0.f; for (int i = 0; i < 128; ++i) s += wv[i] * bf2f(*(const LAS bf16_t*)(KTl + i * 528 + tid * 2)); wsNLOC[(size_t)u * 256 + tid] = s; }
            __syncthreads();
        }
    }
    SEAM(4);

    REP(5) if (IN(5)) { PH_IDS
        for (int st_ = 0; st_ < 3; ++st_) { const int which = (bid & 1) ? (st_ + 2) % 3 : st_;
        __syncthreads();
        if (which == 0) for (int u = bid; u < 288; u += G) {
            LAS float* tile = (LAS float*)lds;
            __syncthreads();
            if (u < 256) {
                const int b = u >> 6, ch = u & 63, m0 = b * TT + ch * 32;
                float h0 = 0.f, h1 = 0.f;
                const f32x2 ba = *(const f32x2*)(args.in[I_BA] + 2 * tid), bx = *(const f32x2*)(args.in[I_BX] + 2 * tid), sp = *(const f32x2*)(wsSPL + 2 * tid);
#pragma unroll 8
                for (int cc = 0; cc < ch; ++cc) { const f32x4 q = *(const f32x4*)(wsSUM + ((size_t)(b * 64 + cc) * 1024 + 2 * tid) * 2); h0 = q[0] * h0 + q[1]; h1 = q[2] * h1 + q[3]; }
#pragma unroll 8
                for (int i = 0; i < 32; ++i) {
                    const size_t o = (size_t)(m0 + i) * 1024 + 2 * tid;
                    const unsigned rw_ = *(const unsigned*)(wsAU + o), iw_ = *(const unsigned*)(wsAU + (size_t)MT * 1024 + o); const f32x2 rp = (f32x2){bflo(rw_), bfhi(rw_)}, ip = (f32x2){bflo(iw_), bfhi(iw_)}; const unsigned xw = *(const unsigned*)(wsXC + o);
                    const f32x2 g0 = gate_one(rp[0], ip[0], ba[0], bx[0], sp[0], bflo(xw)), g1 = gate_one(rp[1], ip[1], ba[1], bx[1], sp[1], bfhi(xw));
                    h0 = g0[0] * h0 + g0[1]; h1 = g1[0] * h1 + g1[1];
                    const unsigned gr = *(const unsigned*)(wsZ + (size_t)(m0 + i) * NZ + OFF_RG + 2 * tid);
                    *(LAS f32x2*)(tile + i * 1024 + 2 * tid) = (f32x2){h0 * gelu_tanh(bflo(gr)), h1 * gelu_tanh(bfhi(gr))};
                }
                if (ch == 63) *(f32x2*)(out + O_PH + (size_t)b * 1024 + 2 * tid) = (f32x2){h0, h1};
            } else {
                const int sb0 = (u - 256) * 4;
                const f32x2 ba = *(const f32x2*)(args.in[I_BA] + 2 * tid), bx = *(const f32x2*)(args.in[I_BX] + 2 * tid), sp = *(const f32x2*)(wsSPL + 2 * tid);
#pragma unroll
                for (int i = 0; i < 4; ++i) {
                    const int sb = sb0 + i, m = MP + sb;
                    const size_t o = (size_t)m * 1024 + 2 * tid;
                    const unsigned rw_ = *(const unsigned*)(wsAU + o), iw_ = *(const unsigned*)(wsAU + (size_t)MT * 1024 + o); const f32x2 rp = (f32x2){bflo(rw_), bfhi(rw_)}, ip = (f32x2){bflo(iw_), bfhi(iw_)}; const unsigned xw = *(const unsigned*)(wsXC + o);
                    const f32x2 g0 = gate_one(rp[0], ip[0], ba[0], bx[0], sp[0], bflo(xw)), g1 = gate_one(rp[1], ip[1], ba[1], bx[1], sp[1], bfhi(xw));
                    const f32x2 hp = *(const f32x2*)(args.in[I_SRH] + (size_t)sb * 1024 + 2 * tid);
                    const float h0 = g0[0] * hp[0] + g0[1], h1 = g1[0] * hp[1] + g1[1];
                    *(f32x2*)(out + O_SH + (size_t)sb * 1024 + 2 * tid) = (f32x2){h0, h1};
                    const unsigned gr = *(const unsigned*)(wsZ + (size_t)m * NZ + OFF_RG + 2 * tid);
                    *(LAS f32x2*)(tile + i * 1024 + 2 * tid) = (f32x2){h0 * gelu_tanh(bflo(gr)), h1 * gelu_tanh(bfhi(gr))};
                }
            }
            __syncthreads();
            const int mrow0 = (u < 256) ? ((u >> 6) * TT + (u & 63) * 32) : (MP + (u - 256) * 4);
            const int nrows = (u < 256) ? 32 : 4;
#pragma unroll
            for (int r = 0; r < 4; ++r) {
                const int i = wave * 4 + r; if (i >= nrows) continue; f32x4 v[4]; float ss = 0.f;
#pragma unroll
                for (int j = 0; j < 4; ++j) { v[j] = *(const LAS f32x4*)(tile + i * 1024 + 256 * j + 4 * lane); ss += (v[j][0] * v[j][0] + v[j][1] * v[j][1]) + (v[j][2] * v[j][2] + v[j][3] * v[j][3]); }
                const float rstd = rsqrtf(wave_sum(ss) * (1.f / 1024.f) + EPS);
#pragma unroll
                for (int j = 0; j < 4; ++j) { const f32x4 gg = *(const f32x4*)(args.in[I_GRNN] + 256 * j + 4 * lane); const f32x4 o = v[j] * rstd * gg;
                    u32x2 w; w.x = pk2(o[0], o[1]); w.y = pk2(o[2], o[3]); *(u32x2*)(wsY + (size_t)(mrow0 + i) * D + 256 * j + 4 * lane) = w; }
            }
        }
        if (which == 1) for (int u = bid; u < 256; u += G) {
            const int bh = u >> 4, sl = u & 15, v = 16 * sl + (tid >> 5), k0 = (tid & 31) * 8;
            float cs[8];
#pragma unroll
            for (int e = 0; e < 8; ++e) cs[e] = 0.f;
            float m = 0.f, ns = 0.f;
#pragma unroll
            for (int c = 0; c < 16; ++c) {
                const int cu = bh * 16 + c; const float mloc = wsMSTAT[cu * 2], bL = wsMSTAT[cu * 2 + 1];
                const float mn = fmaxf(bL + m, mloc), al = __expf(bL + m - mn), be = __expf(mloc - mn);
                u32x4 w; w.x = pk2(cs[0], cs[1]); w.y = pk2(cs[2], cs[3]); w.z = pk2(cs[4], cs[5]); w.w = pk2(cs[6], cs[7]);
                *(u32x4*)(wsCIN + (size_t)cu * 65536 + (size_t)v * 256 + k0) = w;
                const u32x4 l = *(const u32x4*)(wsCLOC + (size_t)cu * 65536 + (size_t)v * 256 + k0);
                cs[0] = al * cs[0] + be * bflo(l.x); cs[1] = al * cs[1] + be * bfhi(l.x); cs[2] = al * cs[2] + be * bflo(l.y); cs[3] = al * cs[3] + be * bfhi(l.y);
                cs[4] = al * cs[4] + be * bflo(l.z); cs[5] = al * cs[5] + be * bfhi(l.z); cs[6] = al * cs[6] + be * bflo(l.w); cs[7] = al * cs[7] + be * bfhi(l.w);
                if (sl == 0 && tid < 256) { wsNIN[(size_t)cu * 256 + tid] = ns; ns = al * ns + be * wsNLOC[(size_t)cu * 256 + tid]; }
                if (sl == 0 && tid == 0) wsMINB[cu] = m;
                m = mn;
            }
            float* oc = out + O_PC + (size_t)bh * 65536 + (size_t)v * 256 + k0;
            *(f32x4*)oc = (f32x4){cs[0], cs[1], cs[2], cs[3]}; *(f32x4*)(oc + 4) = (f32x4){cs[4], cs[5], cs[6], cs[7]};
            if (sl == 0 && tid < 256) out[O_PN + (size_t)bh * 256 + tid] = ns;
            if (sl == 0 && tid == 0) out[O_PM + bh] = m;
        }
        if (which == 2) for (int u = bid; u < 512; u += G) {
            const int sb = u >> 2, h = u & 3, m = MP + sb;
            LAS float* red = misc;
            LAS float* hv = misc + 16;
            __syncthreads();
            const float ig = wsGATES[(size_t)m * 8 + h] + args.in[I_BI][h], lf = logsigmoid_(wsGATES[(size_t)m * 8 + 4 + h] + args.in[I_BF][h]);
            const float mp = args.in[I_SMM][sb * 4 + h];
            const float inter = lf + mp, mt = fmaxf(inter, ig), wi = __expf(inter - mt), sd = __expf(ig - mt);
            const u32x2 qw = *(const u32x2*)(wsQm + (size_t)m * 1024 + h * 256 + 4 * lane), kw = *(const u32x2*)(wsKm + (size_t)m * 1024 + h * 256 + 4 * lane);
            const f32x4 qv = (f32x4){bflo(qw.x), bfhi(qw.x), bflo(qw.y), bfhi(qw.y)}, kv = (f32x4){bflo(kw.x), bfhi(kw.x), bflo(kw.y), bfhi(kw.y)};
            const f32x4 nv = *(const f32x4*)(args.in[I_SMN] + (size_t)u * 256 + 4 * lane);
            const float qk = wave_sum((qv[0] * kv[0] + qv[1] * kv[1]) + (qv[2] * kv[2] + qv[3] * kv[3]));
            const float nq = wave_sum((qv[0] * nv[0] + qv[1] * nv[1]) + (qv[2] * nv[2] + qv[3] * nv[3]));
            const float s = qk * sd, den = wi * nq + s, dn = fmaxf(fabsf(den), __expf(-mt));
            if (wave == 0) { *(f32x4*)(out + O_SN + (size_t)u * 256 + 4 * lane) = wi * nv + sd * kv; if (lane == 0) out[O_SM + u] = mt; }
            const float* Cs = args.in[I_SMC_] + (size_t)u * 65536; float* Co = out + O_SC + (size_t)u * 65536;
            float pc[32];
            const bf16_t* vrow = wsZ + (size_t)m * NZ + OFF_MV + h * 256 + 32 * wave;
#pragma unroll
            for (int r = 0; r < 32; ++r) {
                const int v = 32 * wave + r;
                const f32x4 c4 = __builtin_nontemporal_load((const f32x4*)(Cs + (size_t)v * 256 + 4 * lane));
                const float vv = bf2f(vrow[r]);
                pc[r] = (c4[0] * qv[0] + c4[1] * qv[1]) + (c4[2] * qv[2] + c4[3] * qv[3]);
                __builtin_nontemporal_store(wi * c4 + (sd * vv) * kv, (f32x4*)(Co + (size_t)v * 256 + 4 * lane));
            }
            reduce32(pc, lane);
            float hsq = 0.f;
            { const float vv = bf2f(vrow[lane >> 1]); const float hval = (wi * pc[0] + s * vv) / dn;
              if ((lane & 1) == 0) { hv[32 * wave + (lane >> 1)] = hval; hsq = hval * hval; } }
            hsq = wave_sum(hsq);
            if (lane == 0) red[wave] = hsq;
            __syncthreads();
            if (tid < 256) {
                float tot = 0.f;
#pragma unroll
                for (int w = 0; w < 8; ++w) tot += red[w];
                const float rstd = rsqrtf(tot * (1.f / 256.f) + EPS);
                const float og = bf2f(wsZ[(size_t)m * NZ + OFF_MO + h * 256 + tid]);
                wsY[(size_t)m * D + 1024 + h * 256 + tid] = (bf16_t)f2bf(hv[tid] * rstd * args.in[I_GML][tid] * sigmoidf_(og));
            }
        }
        }
        __syncthreads();
    }
    SEAM(5);

    REP(6) if (IN(6)) { PH_IDS
        for (int u = bid; u < 256; u += G) {
            const int bh = u >> 4, c = u & 15, b = bh >> 2, h = bh & 3, m0 = b * TT + c * 128;
            LAS float* ev = misc; LAS float* bb = misc + 128; LAS float* pmx = misc + 256; LAS float* nin = misc + 384;
            LAS unsigned char* Vl = lds;
            __syncthreads();
            if (tid < 128) { ev[tid] = wsGATES[(size_t)(m0 + tid) * 8 + h] + args.in[I_BI][h]; bb[tid] = logsigmoid_(wsGATES[(size_t)(m0 + tid) * 8 + 4 + h] + args.in[I_BF][h]); }
            if (tid >= 256) nin[tid - 256] = wsNIN[(size_t)u * 256 + tid - 256];
            __syncthreads();
            if (wave == 0) {
                const float x0 = bb[2 * lane], x1 = bb[2 * lane + 1], loc = x0 + x1; float inc = loc;
#pragma unroll
                for (int o = 1; o < 64; o <<= 1) { const float t = __shfl_up(inc, o); if (lane >= o) inc += t; }
                const float b0 = inc - x1, b1 = inc, e0 = ev[2 * lane] - b0, e1 = ev[2 * lane + 1] - b1;
                float im = fmaxf(e0, e1);
#pragma unroll
                for (int o = 1; o < 64; o <<= 1) { const float t = __shfl_up(im, o); if (lane >= o) im = fmaxf(im, t); }
                float ex = __shfl_up(im, 1); if (lane == 0) ex = -INFINITY;
                bb[2 * lane] = b0; bb[2 * lane + 1] = b1; ev[2 * lane] = e0; ev[2 * lane + 1] = e1;
                pmx[2 * lane] = fmaxf(ex, e0); pmx[2 * lane + 1] = im;
            }
            for (int idx = tid; idx < 128 * 32; idx += 512) { const int s = idx >> 5, ch = idx & 31;
                *(LAS u32x4*)(Vl + s * 528 + ch * 16) = *(const u32x4*)(wsZ + (size_t)(m0 + s) * NZ + OFF_MV + h * 256 + ch * 8); }
            __syncthreads();
            const float mc = wsMINB[u];
            const int fr = lane & 15, g4 = lane >> 4, q = fr >> 2, p = fr & 3, t = 16 * wave + fr;
            const bf16_t* qp = wsQm + (size_t)(m0 + t) * 1024 + h * 256 + 8 * g4;
            f32x4 sacc[8];
#pragma unroll
            for (int st = 0; st < 8; ++st) sacc[st] = (f32x4){0.f, 0.f, 0.f, 0.f};
#pragma unroll 2
            for (int ks = 0; ks < 8; ++ks) {
                const bf16x8 qf = ld8(qp + 32 * ks);
                const bf16_t* kp = wsKm + (size_t)(m0 + fr) * 1024 + h * 256 + 32 * ks + 8 * g4;
#pragma unroll
                for (int st = 0; st < 8; ++st) if (st <= wave) { const bf16x8 xk = ld8(kp + (size_t)(16 * st) * 1024); sacc[st] = MFMA16(xk, qf, sacc[st]); }
            }
            const float Mt = fmaxf(mc, pmx[t]);
            float rs = 0.f;
#pragma unroll
            for (int st = 0; st < 8; ++st) { const f32x4 e4 = *(const LAS f32x4*)(ev + 16 * st + 4 * g4);
#pragma unroll
                for (int r = 0; r < 4; ++r) { const int s = 16 * st + 4 * g4 + r; const float pv = (s <= t) ? sacc[st][r] * __expf(e4[r] - Mt) : 0.f; sacc[st][r] = pv; rs += pv; } }
            float nq = 0.f;
            f32x4 oacc[16];
#pragma unroll
            for (int vt = 0; vt < 16; ++vt) oacc[vt] = (f32x4){0.f, 0.f, 0.f, 0.f};
            const bf16_t* cin = wsCIN + (size_t)u * 65536 + (size_t)fr * 256 + 8 * g4;
#pragma unroll 2
            for (int ks = 0; ks < 8; ++ks) {
                const bf16x8 qf = ld8(qp + 32 * ks);
                const f32x4 n0 = *(const LAS f32x4*)(nin + 32 * ks + 8 * g4), n1 = *(const LAS f32x4*)(nin + 32 * ks + 8 * g4 + 4);
                nq += (bf2f((unsigned short)qf[0]) * n0[0] + bf2f((unsigned short)qf[1]) * n0[1]) + (bf2f((unsigned short)qf[2]) * n0[2] + bf2f((unsigned short)qf[3]) * n0[3])
                    + (bf2f((unsigned short)qf[4]) * n1[0] + bf2f((unsigned short)qf[5]) * n1[1]) + (bf2f((unsigned short)qf[6]) * n1[2] + bf2f((unsigned short)qf[7]) * n1[3]);
#pragma unroll
                for (int vt = 0; vt < 16; ++vt) { const bf16x8 xc = ld8(cin + (size_t)(16 * vt) * 256 + 32 * ks); oacc[vt] = MFMA16(xc, qf, oacc[vt]); }
            }
            rs += __shfl_xor(rs, 16); rs += __shfl_xor(rs, 32); nq += __shfl_xor(nq, 16); nq += __shfl_xor(nq, 32);
            const float wi = __expf(mc - Mt), den = wi * nq + rs, dn = fmaxf(fabsf(den), __expf(-(bb[t] + Mt)));
#pragma unroll
            for (int vt = 0; vt < 16; ++vt) oacc[vt] = oacc[vt] * wi;
#pragma unroll
            for (int pb = 0; pb < 4; ++pb) if (2 * pb <= wave) {
                u32x4 pw; pw.x = pk2(sacc[2 * pb][0], sacc[2 * pb][1]); pw.y = pk2(sacc[2 * pb][2], sacc[2 * pb][3]); pw.z = pk2(sacc[2 * pb + 1][0], sacc[2 * pb + 1][1]); pw.w = pk2(sacc[2 * pb + 1][2], sacc[2 * pb + 1][3]);
                const bf16x8 yp = __builtin_bit_cast(bf16x8, pw);
                const int rb = (32 * pb + 4 * g4 + q) * 528 + 8 * p;
#pragma unroll
                for (int vt = 0; vt < 16; ++vt) { const bf16x8 xv = cat8(tr_read(Vl + rb + 32 * vt), tr_read(Vl + rb + 16 * 528 + 32 * vt)); oacc[vt] = MFMA16(xv, yp, oacc[vt]); }
            }
            const float inv = 1.f / dn; float ss = 0.f;
#pragma unroll
            for (int vt = 0; vt < 16; ++vt) { oacc[vt] = oacc[vt] * inv; ss += (oacc[vt][0] * oacc[vt][0] + oacc[vt][1] * oacc[vt][1]) + (oacc[vt][2] * oacc[vt][2] + oacc[vt][3] * oacc[vt][3]); }
            ss += __shfl_xor(ss, 16); ss += __shfl_xor(ss, 32);
            const float rstd = rsqrtf(ss * (1.f / 256.f) + EPS);
#pragma unroll
            for (int vt = 0; vt < 16; ++vt) {
                const int v0 = 16 * vt + 4 * g4; const f32x4 gg = *(const f32x4*)(args.in[I_GML] + v0);
                const u32x2 ow = *(const u32x2*)(wsZ + (size_t)(m0 + t) * NZ + OFF_MO + h * 256 + v0);
                const float o0 = oacc[vt][0] * rstd * gg[0] * sigmoidf_(bflo(ow.x)), o1 = oacc[vt][1] * rstd * gg[1] * sigmoidf_(bfhi(ow.x));
                const float o2 = oacc[vt][2] * rstd * gg[2] * sigmoidf_(bflo(ow.y)), o3 = oacc[vt][3] * rstd * gg[3] * sigmoidf_(bfhi(ow.y));
                u32x2 w; w.x = pk2(o0, o1); w.y = pk2(o2, o3); *(u32x2*)(wsY + (size_t)(m0 + t) * D + 1024 + h * 256 + v0) = w;
            }
        }
        __syncthreads();
    }
    SEAM(6);

    REP(7) if (IN(7)) { PH_IDS
        { const pg8::Gemm g = pg8::mk_gemm(wsY, wsWoutT, D * 2, D * 2, D, 0); pg8::StaticOrder S; S.init(32, 8, G, bid);
          EpiResNorm<float> E{args.in[I_XP], wsX1, wsXN, args.in[I_GX], wsSS}; pg8::gemm_phase<EpiResNorm<float>, true, true>(lds, g, S, E, wave); }
        skinny_gemm(wsY + (size_t)MP * D, D, wsWoutT, D, D, D, 1, 0, 64, MP, FResNorm<float>{args.in[I_XS], MP, wsX1, wsXN, args.in[I_GX], wsSS}, 0, wave, (LAS float*)lds);
        if (bid >= 64) { convert_matrix(args.in[I_WCQ], D, D, D, wsWcqT, D, (LAS float*)(lds + wave * 16384), (bid - 64) * 8 + wave, (G - 64) * 8, lane);
                         convert_matrix(args.in[I_WCO], D, D, D, wsWcoT, D, (LAS float*)(lds + wave * 16384), (bid - 64) * 8 + wave, (G - 64) * 8, lane); }
    }
    SEAM(7);

    REP(9) if (IN(9)) { PH_IDS
        const float qs = 0.04419417382415922f;
        { const pg8::Gemm g = pg8::mk_gemm(wsXN, wsWcqT, D * 2, D * 2, D, 0); pg8::StaticOrder S; S.init(32, 8, G, bid);
          pg8::EpiF8<FStoreBf16> E{{wsQC, D, qs, 0, wsSS}}; pg8::gemm_phase<pg8::EpiF8<FStoreBf16>, true, true>(lds, g, S, E, wave); }
        skinny_gemm(wsXN + (size_t)MP * D, D, wsWcqT, D, D, D, 1, 0, 64, MP, FStoreBf16{wsQC, D, qs, 0, wsSS}, 0, wave, (LAS float*)lds);
        if (bid >= 64) convert_matrix(args.in[I_WUP], DFF, D, DFF, wsWupT, D, (LAS float*)(lds + wave * 16384), (bid - 64) * 8 + wave, (G - 64) * 8, lane);
    }
    SEAM(9);

    REP(10) if (IN(10)) { PH_IDS
        { pg8::Gemm g{(const char*)wsQC, (const char*)wsMK, D * 2, D * 2, 512, (size_t)256 * D * 2, 0, 1024, 1024, (size_t)256 * D * 2, 0x7fffffff, 0x7fffffff, 0, 0}; pg8::StaticOrder S; S.init(32, 4, G, bid);
          EpiSoftmax E{wsPB, misc}; pg8::gemm_phase<EpiSoftmax, true, true>(lds, g, S, E, wave); }
        { pg8::Gemm g{(const char*)wsWcoT, (const char*)wsMVt, D * 2, D * 2, 512, (size_t)256 * D * 2, 0, 1024, 1024, 0, 3, 3, 2, (size_t)256 * D * 2}; pg8::StaticOrder S; S.init(8, 16, G, bid - 128);
          pg8::EpiF8<FVw> E{{wsVW}}; pg8::gemm_phase<pg8::EpiF8<FVw>, true, true>(lds, g, S, E, wave); }
        for (int u = bid; u < 512; u += G) {
            const int sb = u >> 2, h = u & 3, m = MP + sb;
            LAS float* scr = misc;
            LAS float* part = (LAS float*)lds;
            __syncthreads();
            const u32x2 qa = *(const u32x2*)(wsQC + (size_t)m * D + h * 512 + 4 * lane), qb = *(const u32x2*)(wsQC + (size_t)m * D + h * 512 + 256 + 4 * lane);
            const f32x4 q0 = (f32x4){bflo(qa.x), bfhi(qa.x), bflo(qa.y), bfhi(qa.y)}, q1 = (f32x4){bflo(qb.x), bfhi(qb.x), bflo(qb.y), bfhi(qb.y)};
            const float* kb = args.in[I_CK] + ((size_t)sb * 256 * 4 + h) * 512 + 4 * lane + (size_t)(32 * wave) * 2048;
            const float* vb = args.in[I_CV] + ((size_t)sb * 256 * 4 + h) * 512 + 4 * lane + (size_t)(32 * wave) * 2048;
            float pa[32];
#pragma unroll
            for (int i = 0; i < 32; ++i) { const f32x4 a = __builtin_nontemporal_load((const f32x4*)(kb + (size_t)i * 2048)), c4 = __builtin_nontemporal_load((const f32x4*)(kb + (size_t)i * 2048 + 256));
                pa[i] = ((a[0] * q0[0] + a[1] * q0[1]) + (a[2] * q0[2] + a[3] * q0[3])) + ((c4[0] * q1[0] + c4[1] * q1[1]) + (c4[2] * q1[2] + c4[3] * q1[3])); }
            reduce32(pa, lane);
            if ((lane & 1) == 0) scr[32 * wave + (lane >> 1)] = pa[0];
            __syncthreads();
            const f32x4 s4 = *(const LAS f32x4*)(scr + 4 * lane);
            const float mx = wave_max(fmaxf(fmaxf(s4[0], s4[1]), fmaxf(s4[2], s4[3])));
            const float sm = wave_sum((__expf(s4[0] - mx) + __expf(s4[1] - mx)) + (__expf(s4[2] - mx) + __expf(s4[3] - mx)));
            const float inv = 1.f / sm;
            f32x4 o0 = (f32x4){0.f, 0.f, 0.f, 0.f}, o1 = (f32x4){0.f, 0.f, 0.f, 0.f};
#pragma unroll 16
            for (int i = 0; i < 32; ++i) { const float pr = __expf(scr[32 * wave + i] - mx) * inv;
                const f32x4 a = __builtin_nontemporal_load((const f32x4*)(vb + (size_t)i * 2048)), c4 = __builtin_nontemporal_load((const f32x4*)(vb + (size_t)i * 2048 + 256));
                o0 = o0 + pr * a; o1 = o1 + pr * c4; }
            *(LAS f32x4*)(part + wave * 512 + 4 * lane) = o0; *(LAS f32x4*)(part + wave * 512 + 256 + 4 * lane) = o1;
            __syncthreads();
            float tot = 0.f;
#pragma unroll
            for (int w = 0; w < 8; ++w) tot += part[w * 512 + tid];
            wsOC[(size_t)m * D + h * 512 + tid] = (bf16_t)f2bf(tot);
        }
        __syncthreads();
    }
    SEAM(10);

    REP(11) if (IN(11)) { PH_IDS
        { pg8::Gemm g{(const char*)wsPB, (const char*)wsVW, 2048, 2048, 1024, (size_t)256 * 2048, 0, 0, (size_t)256 * 2048, (size_t)D * 2048, 0x7fffffff, 0x7fffffff, 0, 0}; pg8::StaticOrder S; S.init(32, 8, G, bid);
          EpiResNorm<bf16_t> E{wsX1, wsX2, wsXN, args.in[I_GFFN], wsSS + MT}; pg8::gemm_phase<EpiResNorm<bf16_t>, true, true>(lds, g, S, E, wave); }
        skinny_gemm(wsOC + (size_t)MP * D, D, wsWcoT, D, D, D, 1, 0, 64, MP, FResNorm<bf16_t>{wsX1, 0, wsX2, wsXN, args.in[I_GFFN], wsSS + MT}, 0, wave, (LAS float*)lds);
        if (bid >= 64) convert_matrix(args.in[I_WDN], D, DFF, D, wsWdnT, DFF, (LAS float*)(lds + wave * 16384), (bid - 64) * 8 + wave, (G - 64) * 8, lane);
    }
    SEAM(11);

    REP(13) if (IN(13)) { PH_IDS
        { const pg8::Gemm g = pg8::mk_gemm(wsXN, wsWupT, D * 2, D * 2, D, 0); pg8::StaticOrder S; S.init(32, 32, G, bid);
          pg8::EpiF8<FStoreBf16> E{{wsU, DFF, 1.f, 1, wsSS + MT}}; pg8::gemm_phase<pg8::EpiF8<FStoreBf16>, true, true>(lds, g, S, E, wave); }
        skinny_gemm(wsXN + (size_t)MP * D, D, wsWupT, D, D, DFF, 1, 0, 256, MP, FStoreBf16{wsU, DFF, 1.f, 1, wsSS + MT}, 0, wave, (LAS float*)lds);
    }
    SEAM(13);

    REP(14) if (IN(14)) { PH_IDS
        { const pg8::Gemm g = pg8::mk_gemm(wsU, wsWdnT, DFF * 2, DFF * 2, DFF, 0); pg8::StaticOrder S; S.init(32, 8, G, bid);
          pg8::EpiF8<FResB> E{{wsX2, wsX1}}; pg8::gemm_phase<pg8::EpiF8<FResB>, true, true>(lds, g, S, E, wave); }
        skinny_gemm(wsU + (size_t)MP * DFF, DFF, wsWdnT, DFF, DFF, D, 4, 0, 256, 0, FPart{wsPART, D}, 128, wave, (LAS float*)lds);
    }
    SEAM(14);

    REP(15) if (IN(15)) { PH_IDS
        f32x4 gfin[8]; load_gain(args.in[I_GFIN], lane, gfin);
        for (int m = gw; m < MT; m += NGW) {
            f32x4 v[8]; float ss = 0.f;
#pragma unroll
            for (int j = 0; j < 8; ++j) {
                if (m < MP) v[j] = ld4_res(wsX1 + (size_t)m * D + 256 * j + 4 * lane);
                else { const size_t o = (size_t)(m - MP) * D + 256 * j + 4 * lane; v[j] = ld4_res(wsX2 + (size_t)m * D + 256 * j + 4 * lane);
#pragma unroll
                    for (int s = 0; s < 4; ++s) v[j] = v[j] + *(const f32x4*)(wsPART + (size_t)s * 128 * D + o); }
                ss += (v[j][0] * v[j][0] + v[j][1] * v[j][1]) + (v[j][2] * v[j][2] + v[j][3] * v[j][3]);
            }
            const float rstd = rsqrtf(wave_sum(ss) * (1.f / D) + EPS);
            float* o = (m < MP) ? out + O_YP + (size_t)m * D : out + O_YS + (size_t)(m - MP) * D;
#pragma unroll
            for (int j = 0; j < 8; ++j) __builtin_nontemporal_store(v[j] * rstd * gfin[j], (f32x4*)(o + 256 * j + 4 * lane));
        }
    }
#undef IN
#undef SEAM
}

extern "C" void kernel_launch(void* const* d_in, const int* in_sizes, int n_in, void* d_out, int out_size, void* d_ws, size_t ws_size, hipStream_t stream) {
    static int grid = 0;
    if (grid == 0) {
        int dev = 0, cus = 0, per_cu = 0;
        if (n_in != 39 || ws_size < WS_END) { fprintf(stderr, "kernel_launch: unexpected n_in %d / ws %zu\n", n_in, ws_size); grid = -1; return; }
        hipGetDevice(&dev);
        hipDeviceGetAttribute(&cus, hipDeviceAttributeMultiprocessorCount, dev);
        if (hipFuncSetAttribute((const void*)mega_fwd, hipFuncAttributeMaxDynamicSharedMemorySize, LDS_BYTES) != hipSuccess) { fprintf(stderr, "kernel_launch: hipFuncSetAttribute failed\n"); grid = -1; return; }
        if (hipOccupancyMaxActiveBlocksPerMultiprocessor(&per_cu, (const void*)mega_fwd, 512, LDS_BYTES) != hipSuccess || per_cu < 1) { fprintf(stderr, "kernel_launch: occupancy query says %d\n", per_cu); per_cu = 1; }
        (void)hipGetLastError();
        grid = cus;
    }
    if (grid < 0) return;
    Args a{};
    for (int i = 0; i < 39; ++i) a.in[i] = (const float*)d_in[i];
    a.out = (float*)d_out; a.ws = (unsigned char*)d_ws; a.ph_lo = 0; a.ph_hi = NPH;
    if (hipMemsetAsync((char*)d_ws + WS_CTL, 0, 65536, stream) != hipSuccess) { fprintf(stderr, "kernel_launch: memset failed\n"); return; }
    hipLaunchKernelGGL(mega_fwd, dim3(grid), dim3(512), LDS_BYTES, stream, a);
    hipError_t e = hipPeekAtLastError();
    if (e != hipSuccess) fprintf(stderr, "kernel_launch: launch failed: %s (grid %d)\n", hipGetErrorString(e), grid);
}
```

```cpp
#include <hip/hip_runtime.h>
#include <cstdio>
#include <cstdint>

#define LAS __attribute__((address_space(3)))
typedef unsigned short bf16_t;
typedef short bf16x8 __attribute__((ext_vector_type(8)));
typedef short s16x4 __attribute__((ext_vector_type(4)));
typedef float f32x4 __attribute__((ext_vector_type(4)));
typedef float f32x2 __attribute__((ext_vector_type(2)));
typedef unsigned u32x4 __attribute__((ext_vector_type(4)));
typedef unsigned u32x2 __attribute__((ext_vector_type(2)));

constexpr int D = 2048, NB = 4, TT = 2048, MP = NB * TT, MS = 128, MT = MP + MS;
constexpr int DIN = 5128, NZ = 5120, NZP = 5376, DR = 1024, DFF = 8192, NMEM = 256, MMEM = NB * NMEM;
constexpr float EPS = 1e-6f;
constexpr int OFF_RX = 0, OFF_RG = 1024, OFF_MU = 2048, OFF_MV = 3072, OFF_MO = 4096;
constexpr size_t O_YP = 0;
constexpr size_t O_YS = O_YP + (size_t)MP * D;
constexpr size_t O_PH = O_YS + (size_t)MS * D;
constexpr size_t O_PRC = O_PH + 4 * 1024;
constexpr size_t O_PC = O_PRC + 4 * 3 * 1024;
constexpr size_t O_PN = O_PC + (size_t)4 * 4 * 65536;
constexpr size_t O_PM = O_PN + 4 * 4 * 256;
constexpr size_t O_PMC = O_PM + 16;
constexpr size_t O_PK = O_PMC + 4 * 3 * 1024;
constexpr size_t O_PV = O_PK + (size_t)MMEM * D;
constexpr size_t O_SH = O_PV + (size_t)MMEM * D;
constexpr size_t O_SRC = O_SH + 128 * 1024;
constexpr size_t O_SC = O_SRC + 128 * 3 * 1024;
constexpr size_t O_SN = O_SC + (size_t)128 * 4 * 65536;
constexpr size_t O_SM = O_SN + 128 * 4 * 256;
constexpr size_t O_SMC = O_SM + 512;
constexpr size_t MiB = 1u << 20;
constexpr size_t WS_WIN = 0, WS_WOUT = 20 * MiB, WS_WCQ = 28 * MiB, WS_WMK = 36 * MiB, WS_WMV = 44 * MiB, WS_WCO = 52 * MiB;
constexpr size_t WS_WUP = 60 * MiB, WS_WDN = 92 * MiB, WS_WG = 124 * MiB, WS_WQK = 125 * MiB, WS_XN = 126 * MiB, WS_MN = 159 * MiB;
constexpr size_t WS_Z = 163 * MiB, WS_GATES = 245 * MiB, WS_XC = 246 * MiB, WS_UC = 263 * MiB, WS_AU = 280 * MiB, WS_QM = 345 * MiB;
constexpr size_t WS_KM = 362 * MiB, WS_Y = 379 * MiB, WS_X1 = 412 * MiB, WS_X2 = 477 * MiB, WS_QC = 542 * MiB, WS_OC = 575 * MiB;
constexpr size_t WS_MK = 608 * MiB, WS_MVT = 612 * MiB, WS_U = 616 * MiB, WS_CLOC = 746 * MiB, WS_CIN = 778 * MiB, WS_NLOC = 810 * MiB;
constexpr size_t WS_NIN = 811 * MiB, WS_MSTAT = 812 * MiB, WS_SUM = 813 * MiB, WS_PART = 815 * MiB, WS_CTL = 819 * MiB, WS_WIN2 = 820 * MiB, WS_END = 842 * MiB;
constexpr int LDS_BYTES = 147712, MISC_OFF = 139264;
constexpr int NPH = 16;

__device__ __forceinline__ unsigned f2bf(float f) { unsigned u = __builtin_bit_cast(unsigned, f); return (u + 0x7fffu + ((u >> 16) & 1u)) >> 16; }
__device__ __forceinline__ unsigned pk2(float lo, float hi) { return f2bf(lo) | (f2bf(hi) << 16); }
__device__ __forceinline__ float bf2f(unsigned h) { return __builtin_bit_cast(float, (h & 0xffffu) << 16); }
__device__ __forceinline__ float bflo(unsigned w) { return __builtin_bit_cast(float, w << 16); }
__device__ __forceinline__ float bfhi(unsigned w) { return __builtin_bit_cast(float, w & 0xffff0000u); }
__device__ __forceinline__ float wave_sum(float v) {
#pragma unroll
    for (int o = 1; o < 64; o <<= 1) v += __shfl_xor(v, o);
    return v;
}
__device__ __forceinline__ float wave_max(float v) {
#pragma unroll
    for (int o = 1; o < 64; o <<= 1) v = fmaxf(v, __shfl_xor(v, o));
    return v;
}
__device__ __forceinline__ void reduce32(float (&a)[32], int lane) {
#pragma unroll
    for (int i = 0; i < 16; ++i) { const bool up = lane & 32; const float keep = up ? a[i + 16] : a[i], send = up ? a[i] : a[i + 16]; a[i] = keep + __shfl_xor(send, 32); }
#pragma unroll
    for (int i = 0; i < 8; ++i) { const bool up = lane & 16; const float keep = up ? a[i + 8] : a[i], send = up ? a[i] : a[i + 8]; a[i] = keep + __shfl_xor(send, 16); }
#pragma unroll
    for (int i = 0; i < 4; ++i) { const bool up = lane & 8; const float keep = up ? a[i + 4] : a[i], send = up ? a[i] : a[i + 4]; a[i] = keep + __shfl_xor(send, 8); }
#pragma unroll
    for (int i = 0; i < 2; ++i) { const bool up = lane & 4; const float keep = up ? a[i + 2] : a[i], send = up ? a[i] : a[i + 2]; a[i] = keep + __shfl_xor(send, 4); }
    { const bool up = lane & 2; const float keep = up ? a[1] : a[0], send = up ? a[0] : a[1]; a[0] = keep + __shfl_xor(send, 2); }
    a[0] += __shfl_xor(a[0], 1);
}
__device__ __forceinline__ float sigmoidf_(float x) { return 1.f / (1.f + __expf(-x)); }
__device__ __forceinline__ float gelu_tanh(float x) { const float u = 0.7978845608028654f * (x + 0.044715f * x * x * x); return 0.5f * x * (1.f + tanhf(u)); }
__device__ __forceinline__ float logsigmoid_(float x) { return fminf(x, 0.f) - log1pf(__expf(-fabsf(x))); }
__device__ __forceinline__ bf16x8 ld8(const bf16_t* p) { return *(const bf16x8*)p; }
__device__ __forceinline__ s16x4 tr_read(const LAS unsigned char* p) {
    typedef short v4i16_t __attribute__((ext_vector_type(4)));
    return __builtin_bit_cast(s16x4, __builtin_amdgcn_ds_read_tr16_b64_v4i16((LAS v4i16_t*)p));
}
__device__ __forceinline__ bf16x8 cat8(s16x4 a, s16x4 b) { return (bf16x8){a[0], a[1], a[2], a[3], b[0], b[1], b[2], b[3]}; }
__device__ __forceinline__ int lane_id() { int l; asm volatile("v_mbcnt_lo_u32_b32 %0, -1, 0\n\tv_mbcnt_hi_u32_b32 %0, -1, %0" : "=v"(l)); return l; }
#define MFMA16(x, y, c) __builtin_amdgcn_mfma_f32_16x16x32_bf16((x), (y), (c), 0, 0, 0)

namespace pg8 {
constexpr int BM = 256, BK = 64, HALF = 128, HTB = HALF * BK * 2, STAGE_BYTES = 8 * HTB, NXCD = 8, WGM = 8;
__host__ __device__ __forceinline__ int lds_byte(int r, int c) { const int st = (r >> 4) * 2 + (c >> 5), rr = r & 15, cc = c & 31, ob = rr * 64 + cc * 2; return st * 1024 + (ob ^ (((ob >> 9) & 1) << 5)); }
__host__ __device__ __forceinline__ void stage_rc(int b, int& R, int& C) { const int st = b / 1024, sb = b % 1024, swz = sb ^ (((sb >> 9) & 1) << 5); R = (st >> 1) * 16 + swz / 64; C = (st & 1) * 32 + (swz % 64) / 2; }
__host__ __device__ __forceinline__ int perm32(int rho) { const int n = rho >> 4, i = rho & 15; return 8 * (i >> 2) + 4 * n + (i & 3); }
struct Unit { int pm, pn; };
struct Gemm { const char* A; const char* B; int lda, ldb  , K; size_t a_pm; int a_sh; size_t a_pn, b_pn, b_pm8; int a_msk, b_msk, b_sh2; size_t b_pn2; };
__device__ __forceinline__ Gemm mk_gemm(const void* A, const void* B, int lda, int ldb, int K, int acs) { return Gemm{(const char*)A, (const char*)B, lda, ldb, K, (size_t)256 * lda, 1, (size_t)acs, (size_t)256 * ldb, 0, 0x7fffffff, 0x7fffffff, 0, 0}; }
struct StaticOrder {
    int nM, nN, nwg, G, c;
    __device__ void init(int nM_, int nN_, int G_, int c_) { nM = nM_; nN = nN_; nwg = nM * nN; G = G_; c = c_; }
    __device__ bool next(int i, Unit& u) const {
        if (c < 0 || c >= G) return false;
        const long L = (long)i * G + c; if (L >= nwg) return false;
        int wgid = (int)L; { const int q = nwg / NXCD, r = nwg % NXCD, xcd = wgid % NXCD, off = wgid / NXCD; wgid = (xcd < r ? xcd * (q + 1) : r * (q + 1) + (xcd - r) * q) + off; }
        const int nig = WGM * nN, gid = wgid / nig, fm = gid * WGM, gsz = (nM - fm) < WGM ? (nM - fm) : WGM;
        u.pm = fm + ((wgid % nig) % gsz); u.pn = (wgid % nig) / gsz; return true;
    }
};
template <class F> struct EpiF8 {
    static constexpr bool PERM = true;
    F f;
    __device__ __forceinline__ void operator()(const f32x4 (&acc)[2][2][4][2], const Unit& u, int wr, int wc, int fr, int fq) const {
        float rs[2][4];
#pragma unroll
        for (int ai = 0; ai < 2; ++ai)
#pragma unroll
            for (int m = 0; m < 4; ++m) rs[ai][m] = f.rowscale(u.pm * BM + ai * HALF + wr * 64 + m * 16 + fr);
#pragma unroll
        for (int ai = 0; ai < 2; ++ai)
#pragma unroll
            for (int m = 0; m < 4; ++m) {
                const int row = u.pm * BM + ai * HALF + wr * 64 + m * 16 + fr;
#pragma unroll
                for (int bj = 0; bj < 2; ++bj) f.f8(row, u.pn * BM + bj * HALF + wc * 32 + 8 * fq, acc[ai][bj][m][0] * rs[ai][m], acc[ai][bj][m][1] * rs[ai][m]);
            }
    }
};
template <class F> struct EpiF {
    static constexpr bool PERM = false;
    F f;
    __device__ __forceinline__ void operator()(const f32x4 (&acc)[2][2][4][2], const Unit& u, int wr, int wc, int fr, int fq) const {
        float rs[2][4];
#pragma unroll
        for (int ai = 0; ai < 2; ++ai)
#pragma unroll
            for (int m = 0; m < 4; ++m) rs[ai][m] = f.rowscale(u.pm * BM + ai * HALF + wr * 64 + m * 16 + fr);
#pragma unroll
        for (int ai = 0; ai < 2; ++ai)
#pragma unroll
            for (int m = 0; m < 4; ++m) {
                const int row = u.pm * BM + ai * HALF + wr * 64 + m * 16 + fr;
#pragma unroll
                for (int bj = 0; bj < 2; ++bj)
#pragma unroll
                    for (int n = 0; n < 2; ++n) f(row, u.pn * BM + bj * HALF + wc * 32 + n * 16 + 4 * fq, acc[ai][bj][m][n] * rs[ai][m]);
            }
    }
};

template <class Epi, bool ALIGN_EPI, bool SP2>
__device__ __forceinline__ void gemm_phase(LAS unsigned char* lds, const Gemm g, const StaticOrder& S, const Epi& E, const int wid) {
    const int lane = lane_id(), tid = wid * 64 + lane, wr = wid >> 2, wc = wid & 3, fr = lane & 15, fq = lane >> 4;
    const int K = g.K, nt = K / BK;
    unsigned voffA[2], voffB[2];
#pragma unroll
    for (int i = 0; i < 2; ++i) { int R, C; stage_rc(tid * 16 + i * 8192, R, C); const int Rb = Epi::PERM ? ((R & ~31) + perm32(R & 31)) : R; voffA[i] = (unsigned)(R * g.lda + C * 2); voffB[i] = (unsigned)(Rb * g.ldb + C * 2); }
    const size_t kstep = (size_t)(BK * 2);
    const size_t hstepA = (size_t)HALF * g.lda, hstepB = (size_t)HALF * g.ldb;
    const unsigned ldsw = (unsigned)wid * 1024u;
    const int aoff = lds_byte(wr * 64 + fr, fq * 8), boff = lds_byte(wc * 32 + fr, fq * 8);
#define PG8_SA(b, h) (((b) * 2 + (h)) * HTB)
#define PG8_SB(b, h) ((4 + (b) * 2 + (h)) * HTB)
#define PG8_STAGE(bufoff, gbase, voff) do { _Pragma("unroll") for (int _i = 0; _i < 2; ++_i) \
        __builtin_amdgcn_global_load_lds((const unsigned*)((const char*)(gbase) + (voff)[_i]), (LAS unsigned*)(lds + (bufoff) + ldsw + _i * 8192), 16, 0, 0); } while (0)
#define PG8_LDA(dst, b, h) do { _Pragma("unroll") for (int m = 0; m < 4; ++m) _Pragma("unroll") for (int k = 0; k < 2; ++k) dst[m][k] = *(const LAS bf16x8*)(lds + PG8_SA(b, h) + aoff + m * 2048 + k * 1024); } while (0)
#define PG8_LDB(dst, b, h) do { _Pragma("unroll") for (int n = 0; n < 2; ++n) _Pragma("unroll") for (int k = 0; k < 2; ++k) dst[n][k] = *(const LAS bf16x8*)(lds + PG8_SB(b, h) + boff + n * 2048 + k * 1024); } while (0)
#define PG8_MMA(ai, bj, At, Bt) do { __builtin_amdgcn_s_setprio(1); _Pragma("unroll") for (int m = 0; m < 4; ++m) _Pragma("unroll") for (int n = 0; n < 2; ++n) _Pragma("unroll") for (int k = 0; k < 2; ++k) \
        acc[ai][bj][m][n] = __builtin_amdgcn_mfma_f32_16x16x32_bf16(Bt[n][k], At[m][k], acc[ai][bj][m][n], 0, 0, 0); __builtin_amdgcn_s_setprio(0); } while (0)
#define PG8_WAIT_V(n) asm volatile("s_waitcnt vmcnt(" #n ")" ::: "memory")
#define PG8_WAIT_L(n) asm volatile("s_waitcnt lgkmcnt(" #n ")" ::: "memory")
#define PG8_BAR __builtin_amdgcn_s_barrier()
#define PG8_SCHED __builtin_amdgcn_sched_barrier(0)
#define PG8_APTR(u) (g.A + (size_t)(u).pm * g.a_pm + (size_t)(((u).pn >> g.a_sh) & g.a_msk) * g.a_pn)
#define PG8_BPTR(u) (g.B + (size_t)((u).pn & g.b_msk) * g.b_pn + (size_t)((u).pn >> g.b_sh2) * g.b_pn2 + (size_t)((u).pm >> 3) * g.b_pm8)
    Unit cur, nxt; int ui = 0;
    if (!S.next(0, cur)) return;
    f32x4 acc[2][2][4][2];
#pragma unroll
    for (int a = 0; a < 2; ++a)
#pragma unroll
        for (int b = 0; b < 2; ++b)
#pragma unroll
            for (int m = 0; m < 4; ++m)
#pragma unroll
                for (int n = 0; n < 2; ++n) acc[a][b][m][n] = (f32x4){0.f, 0.f, 0.f, 0.f};
    bf16x8 At[4][2], B0[2][2], B1[2][2];
    const char* cA = PG8_APTR(cur); const char* cB = PG8_BPTR(cur);
    if constexpr (SP2) {
        PG8_STAGE(PG8_SB(0, 0), cB, voffB); PG8_STAGE(PG8_SB(0, 1), cB + hstepB, voffB); PG8_STAGE(PG8_SA(0, 0), cA, voffA); PG8_STAGE(PG8_SA(0, 1), cA + hstepA, voffA);
        if (wr == 1) PG8_BAR;
        PG8_WAIT_V(2); PG8_BAR;
        PG8_STAGE(PG8_SB(1, 0), cB + kstep, voffB); PG8_STAGE(PG8_SA(1, 0), cA + kstep, voffA); PG8_STAGE(PG8_SB(1, 1), cB + hstepB + kstep, voffB);
        PG8_WAIT_V(6); PG8_BAR;
    } else {
        PG8_STAGE(PG8_SB(0, 0), cB, voffB); PG8_STAGE(PG8_SA(0, 0), cA, voffA); PG8_STAGE(PG8_SB(0, 1), cB + hstepB, voffB); PG8_STAGE(PG8_SA(0, 1), cA + hstepA, voffA);
        if (wr == 1) PG8_BAR;
        PG8_WAIT_V(4); PG8_BAR;
        PG8_STAGE(PG8_SB(1, 0), cB + kstep, voffB); PG8_STAGE(PG8_SA(1, 0), cA + kstep, voffA); PG8_STAGE(PG8_SB(1, 1), cB + hstepB + kstep, voffB);
        PG8_WAIT_V(6); PG8_BAR;
    }
    for (;;) {
        const bool has_next = S.next(ui + 1, nxt);
        const char* nA = has_next ? PG8_APTR(nxt) : cA; const char* nB = has_next ? PG8_BPTR(nxt) : cB;
#pragma nounroll
        for (int t = 0; t < nt; t += 2) {
            const bool last = (t == nt - 2);
            const char* a1 = cA + (size_t)(t + 1) * kstep;
            const char* a2 = last ? nA : cA + (size_t)(t + 2) * kstep; const char* b2 = last ? nB : cB + (size_t)(t + 2) * kstep;
            const char* a3 = a2 + kstep; const char* b3 = b2 + kstep;
            if constexpr (SP2) {
            PG8_LDB(B0, 0, 0); PG8_LDB(B1, 0, 1); PG8_SCHED; PG8_LDA(At, 0, 0); PG8_STAGE(PG8_SA(1, 1), a1 + hstepA, voffA);
            PG8_WAIT_V(8); PG8_WAIT_L(0); PG8_BAR; PG8_MMA(0, 0, At, B0); PG8_MMA(0, 1, At, B1); PG8_BAR; PG8_SCHED;
            PG8_LDA(At, 0, 1); PG8_STAGE(PG8_SB(0, 0), b2, voffB); PG8_STAGE(PG8_SB(0, 1), b2 + hstepB, voffB); PG8_STAGE(PG8_SA(0, 0), a2, voffA);
            PG8_WAIT_V(8); PG8_WAIT_L(0); PG8_BAR; PG8_MMA(1, 0, At, B0); PG8_MMA(1, 1, At, B1); PG8_BAR; PG8_SCHED;
            PG8_LDB(B0, 1, 0); PG8_LDB(B1, 1, 1); PG8_SCHED; PG8_LDA(At, 1, 0); PG8_STAGE(PG8_SA(0, 1), a2 + hstepA, voffA);
            PG8_WAIT_V(8); PG8_WAIT_L(0); PG8_BAR; PG8_MMA(0, 0, At, B0); PG8_MMA(0, 1, At, B1); PG8_BAR; PG8_SCHED;
            PG8_LDA(At, 1, 1); PG8_STAGE(PG8_SB(1, 0), b3, voffB); PG8_STAGE(PG8_SB(1, 1), b3 + hstepB, voffB); PG8_STAGE(PG8_SA(1, 0), a3, voffA);
            PG8_WAIT_V(8); PG8_WAIT_L(0); PG8_BAR; PG8_MMA(1, 0, At, B0); PG8_MMA(1, 1, At, B1); PG8_BAR; PG8_SCHED;
            } else {
            PG8_LDB(B0, 0, 0); PG8_SCHED; PG8_LDA(At, 0, 0); PG8_STAGE(PG8_SA(1, 1), a1 + hstepA, voffA);
            PG8_WAIT_L(8); PG8_BAR; PG8_WAIT_L(0); PG8_MMA(0, 0, At, B0); PG8_BAR; PG8_SCHED;
            PG8_LDB(B1, 0, 1); PG8_STAGE(PG8_SB(0, 0), b2, voffB);
            PG8_BAR; PG8_WAIT_L(0); PG8_MMA(0, 1, At, B1); PG8_BAR;
            PG8_LDA(At, 0, 1); PG8_STAGE(PG8_SA(0, 0), a2, voffA);
            PG8_BAR; PG8_WAIT_L(0); PG8_MMA(1, 0, At, B0); PG8_BAR; PG8_SCHED;
            PG8_STAGE(PG8_SB(0, 1), b2 + hstepB, voffB);
            PG8_WAIT_V(6); PG8_BAR; PG8_MMA(1, 1, At, B1); PG8_BAR;
            PG8_LDB(B0, 1, 0); PG8_SCHED; PG8_LDA(At, 1, 0); PG8_STAGE(PG8_SA(0, 1), a2 + hstepA, voffA);
            PG8_WAIT_L(8); PG8_BAR; PG8_WAIT_L(0); PG8_MMA(0, 0, At, B0); PG8_BAR; PG8_SCHED;
            PG8_LDB(B1, 1, 1); PG8_STAGE(PG8_SB(1, 0), b3, voffB);
            PG8_BAR; PG8_WAIT_L(0); PG8_MMA(0, 1, At, B1); PG8_BAR;
            PG8_LDA(At, 1, 1); PG8_STAGE(PG8_SA(1, 0), a3, voffA);
            PG8_BAR; PG8_WAIT_L(0); PG8_MMA(1, 0, At, B0); PG8_BAR; PG8_SCHED;
            PG8_STAGE(PG8_SB(1, 1), b3 + hstepB, voffB);
            PG8_WAIT_V(6); PG8_BAR; PG8_MMA(1, 1, At, B1); PG8_BAR;
            }
        }
        if constexpr (ALIGN_EPI) { if (wr == 0) PG8_BAR; }
        E(acc, cur, wr, wc, fr, fq);
        if (!has_next) break;
#pragma unroll
        for (int a = 0; a < 2; ++a)
#pragma unroll
            for (int b = 0; b < 2; ++b)
#pragma unroll
                for (int m = 0; m < 4; ++m)
#pragma unroll
                    for (int n = 0; n < 2; ++n) acc[a][b][m][n] = (f32x4){0.f, 0.f, 0.f, 0.f};
        cur = nxt; cA = nA; cB = nB; ++ui;
        if constexpr (ALIGN_EPI) { if (wr == 1) PG8_BAR; }
    }
    PG8_WAIT_V(0);
    if constexpr (!ALIGN_EPI) { if (wr == 0) PG8_BAR; }
    PG8_BAR;
#undef PG8_SA
#undef PG8_SB
#undef PG8_STAGE
#undef PG8_LDA
#undef PG8_LDB
#undef PG8_MMA
#undef PG8_WAIT_V
#undef PG8_WAIT_L
#undef PG8_BAR
#undef PG8_SCHED
#undef PG8_APTR
#undef PG8_BPTR
}
}

struct FStoreBf16 { bf16_t* O; int ld; float scale; int act; const float* ss;
    __device__ __forceinline__ float rowscale(int row) const { return ss ? scale * rsqrtf(ss[row] * (1.f / D) + EPS) : scale; }
    __device__ __forceinline__ void operator()(int row, int col, f32x4 v) const {
        if (act == 1) {
#pragma unroll
            for (int e = 0; e < 4; ++e) { const float r = fmaxf(v[e], 0.f); v[e] = r * r; }
        }
        u32x2 w; w.x = pk2(v[0], v[1]); w.y = pk2(v[2], v[3]); *(u32x2*)(O + (size_t)row * ld + col) = w; }
    __device__ __forceinline__ void f8(int row, int col, f32x4 a, f32x4 b) const {
        if (act == 1) {
#pragma unroll
            for (int e = 0; e < 4; ++e) { const float r = fmaxf(a[e], 0.f); a[e] = r * r; const float s = fmaxf(b[e], 0.f); b[e] = s * s; }
        }
        u32x4 w; w.x = pk2(a[0], a[1]); w.y = pk2(a[2], a[3]); w.z = pk2(b[0], b[1]); w.w = pk2(b[2], b[3]); *(u32x4*)(O + (size_t)row * ld + col) = w; } };
struct FResF32 { const float* base; int brow0; float* out; int ld;
    __device__ __forceinline__ float rowscale(int) const { return 1.f; }
    __device__ __forceinline__ void operator()(int row, int col, f32x4 v) const {
        const f32x4 b = *(const f32x4*)(base + (size_t)(row - brow0) * ld + col); *(f32x4*)(out + (size_t)row * ld + col) = b + v; } };
struct FZ { bf16_t* Zp; float* Gp;
    __device__ __forceinline__ float rowscale(int) const { return 1.f; }
    __device__ __forceinline__ void operator()(int row, int col, f32x4 v) const {
        if (row >= MT) return;
        if (col < NZ) { u32x2 w; w.x = pk2(v[0], v[1]); w.y = pk2(v[2], v[3]); *(u32x2*)(Zp + (size_t)row * NZ + col) = w; }
        else if (col < NZ + 8) *(f32x4*)(Gp + (size_t)row * 8 + (col - NZ)) = v; }
    __device__ __forceinline__ void f8(int row, int col, f32x4 a, f32x4 b) const {
        if (row >= MT) return;
        if (col < NZ) { u32x4 w; w.x = pk2(a[0], a[1]); w.y = pk2(a[2], a[3]); w.z = pk2(b[0], b[1]); w.w = pk2(b[2], b[3]); *(u32x4*)(Zp + (size_t)row * NZ + col) = w; }
        else if (col == NZ) { *(f32x4*)(Gp + (size_t)row * 8) = a; *(f32x4*)(Gp + (size_t)row * 8 + 4) = b; } } };
__device__ __forceinline__ f32x4 ld4_res(const float* p) { return __builtin_nontemporal_load((const f32x4*)p); }
__device__ __forceinline__ f32x4 ld4_res(const bf16_t* p) { const u32x2 w = *(const u32x2*)p; return (f32x4){bflo(w.x), bfhi(w.x), bflo(w.y), bfhi(w.y)}; }
template <class BT> struct FResNorm { const BT* base; int brow0; bf16_t* out; bf16_t* xn; const float* g; float* ssq;
    __device__ __forceinline__ float rowscale(int) const { return 1.f; }
    __device__ __forceinline__ void operator()(int row, int col, f32x4 v) const {
        const f32x4 x = ld4_res(base + (size_t)(row - brow0) * D + col) + v;
        u32x2 o; o.x = pk2(x[0], x[1]); o.y = pk2(x[2], x[3]); *(u32x2*)(out + (size_t)row * D + col) = o;
        const f32x4 gg = *(const f32x4*)(g + col); u32x2 w; w.x = pk2(x[0] * gg[0], x[1] * gg[1]); w.y = pk2(x[2] * gg[2], x[3] * gg[3]); *(u32x2*)(xn + (size_t)row * D + col) = w;
        atomicAdd(ssq + row, (x[0] * x[0] + x[1] * x[1]) + (x[2] * x[2] + x[3] * x[3])); } };
template <class BT> struct EpiResNorm { static constexpr bool PERM = true; const BT* base; bf16_t* out; bf16_t* xn; const float* g; float* ssq;
    __device__ __forceinline__ void operator()(const f32x4 (&acc)[2][2][4][2], const pg8::Unit& u, int wr, int wc, int fr, int fq) const {
        f32x4 gg[2][2];
#pragma unroll
        for (int bj = 0; bj < 2; ++bj) { const int col = u.pn * 256 + bj * 128 + wc * 32 + 8 * fq; gg[bj][0] = *(const f32x4*)(g + col); gg[bj][1] = *(const f32x4*)(g + col + 4); }
#pragma unroll
        for (int ai = 0; ai < 2; ++ai)
#pragma unroll
            for (int m = 0; m < 4; ++m) {
                const int row = u.pm * 256 + ai * 128 + wr * 64 + m * 16 + fr; float ss = 0.f;
#pragma unroll
                for (int bj = 0; bj < 2; ++bj) { const size_t o = (size_t)row * D + u.pn * 256 + bj * 128 + wc * 32 + 8 * fq;
                    const f32x4 x0 = ld4_res(base + o) + acc[ai][bj][m][0], x1 = ld4_res(base + o + 4) + acc[ai][bj][m][1];
                    u32x4 w; w.x = pk2(x0[0], x0[1]); w.y = pk2(x0[2], x0[3]); w.z = pk2(x1[0], x1[1]); w.w = pk2(x1[2], x1[3]); *(u32x4*)(out + o) = w;
                    const f32x4 y0 = x0 * gg[bj][0], y1 = x1 * gg[bj][1];
                    u32x4 z; z.x = pk2(y0[0], y0[1]); z.y = pk2(y0[2], y0[3]); z.z = pk2(y1[0], y1[1]); z.w = pk2(y1[2], y1[3]); *(u32x4*)(xn + o) = z;
                    ss += ((x0[0] * x0[0] + x0[1] * x0[1]) + (x0[2] * x0[2] + x0[3] * x0[3])) + ((x1[0] * x1[0] + x1[1] * x1[1]) + (x1[2] * x1[2] + x1[3] * x1[3])); }
                ss += __shfl_xor(ss, 16); ss += __shfl_xor(ss, 32);
                if (fq == 0) atomicAdd(ssq + row, ss);
                if (m & 1) asm volatile("" ::: "memory");
            }
    } };
struct FResB { const bf16_t* base; bf16_t* out;
    __device__ __forceinline__ float rowscale(int) const { return 1.f; }
    __device__ __forceinline__ void f8(int row, int col, f32x4 a, f32x4 b) const {
        const size_t o = (size_t)row * D + col; const f32x4 x0 = ld4_res(base + o) + a, x1 = ld4_res(base + o + 4) + b;
        u32x4 w; w.x = pk2(x0[0], x0[1]); w.y = pk2(x0[2], x0[3]); w.z = pk2(x1[0], x1[1]); w.w = pk2(x1[2], x1[3]); *(u32x4*)(out + o) = w; } };
struct EpiSoftmax { static constexpr bool PERM = true; bf16_t* P; LAS float* xch;
    __device__ __forceinline__ void operator()(f32x4 (&acc)[2][2][4][2], const pg8::Unit& u, int wr, int wc, int fr, int fq) const {
        float mx[2][4];
#pragma unroll
        for (int ai = 0; ai < 2; ++ai)
#pragma unroll
            for (int m = 0; m < 4; ++m) {
                float v = -INFINITY;
#pragma unroll
                for (int bj = 0; bj < 2; ++bj)
#pragma unroll
                    for (int n = 0; n < 2; ++n) v = fmaxf(v, fmaxf(fmaxf(acc[ai][bj][m][n][0], acc[ai][bj][m][n][1]), fmaxf(acc[ai][bj][m][n][2], acc[ai][bj][m][n][3])));
                v = fmaxf(v, __shfl_xor(v, 16)); v = fmaxf(v, __shfl_xor(v, 32));
                if (fq == 0) xch[(ai * 128 + wr * 64 + m * 16 + fr) * 4 + wc] = v;
            }
        asm volatile("s_waitcnt lgkmcnt(0)" ::: "memory"); __builtin_amdgcn_s_barrier(); asm volatile("" ::: "memory");
#pragma unroll
        for (int ai = 0; ai < 2; ++ai)
#pragma unroll
            for (int m = 0; m < 4; ++m) {
                const f32x4 t = *(const LAS f32x4*)(xch + (ai * 128 + wr * 64 + m * 16 + fr) * 4);
                mx[ai][m] = fmaxf(fmaxf(t[0], t[1]), fmaxf(t[2], t[3]));
                float s = 0.f;
#pragma unroll
                for (int bj = 0; bj < 2; ++bj)
#pragma unroll
                    for (int n = 0; n < 2; ++n)
#pragma unroll
                        for (int e = 0; e < 4; ++e) { const float p = __expf(acc[ai][bj][m][n][e] - mx[ai][m]); acc[ai][bj][m][n][e] = p; s += p; }
                s += __shfl_xor(s, 16); s += __shfl_xor(s, 32);
                if (fq == 0) xch[1024 + (ai * 128 + wr * 64 + m * 16 + fr) * 4 + wc] = s;
            }
        asm volatile("s_waitcnt lgkmcnt(0)" ::: "memory"); __builtin_amdgcn_s_barrier(); asm volatile("" ::: "memory");
#pragma unroll
        for (int ai = 0; ai < 2; ++ai)
#pragma unroll
            for (int m = 0; m < 4; ++m) {
                const f32x4 t = *(const LAS f32x4*)(xch + 1024 + (ai * 128 + wr * 64 + m * 16 + fr) * 4);
                const float inv = 1.f / ((t[0] + t[1]) + (t[2] + t[3]));
                const int row = u.pm * 256 + ai * 128 + wr * 64 + m * 16 + fr;
#pragma unroll
                for (int bj = 0; bj < 2; ++bj) { const f32x4 a = acc[ai][bj][m][0] * inv, b = acc[ai][bj][m][1] * inv;
                    u32x4 w; w.x = pk2(a[0], a[1]); w.y = pk2(a[2], a[3]); w.z = pk2(b[0], b[1]); w.w = pk2(b[2], b[3]);
                    *(u32x4*)(P + (size_t)row * 1024 + u.pn * 256 + bj * 128 + wc * 32 + 8 * fq) = w; }
            }
    } };
struct FVw { bf16_t* VWt;
    __device__ __forceinline__ float rowscale(int) const { return 1.f; }
    __device__ __forceinline__ void f8(int row, int col, f32x4 a, f32x4 b) const {
        const int bb = col >> 10, hk = col & 1023; u32x4 w; w.x = pk2(a[0], a[1]); w.y = pk2(a[2], a[3]); w.z = pk2(b[0], b[1]); w.w = pk2(b[2], b[3]);
        *(u32x4*)(VWt + ((size_t)bb * D + row) * 1024 + hk) = w; } };
struct FQkSplit { bf16_t* Qm; size_t kdelta;
    __device__ __forceinline__ float rowscale(int) const { return 1.f; }
    __device__ __forceinline__ void operator()(int row, int col, f32x4 v) const {
        const int h = col >> 9, j = col & 511; bf16_t* dst = Qm + (size_t)(j >> 8) * kdelta + (size_t)row * 1024 + h * 256 + (j & 255);
        u32x2 w; w.x = pk2(v[0], v[1]); w.y = pk2(v[2], v[3]); *(u32x2*)dst = w; }
    __device__ __forceinline__ void f8(int row, int col, f32x4 a, f32x4 b) const {
        const int h = col >> 9, j = col & 511; bf16_t* dst = Qm + (size_t)(j >> 8) * kdelta + (size_t)row * 1024 + h * 256 + (j & 255);
        u32x4 w; w.x = pk2(a[0], a[1]); w.y = pk2(a[2], a[3]); w.z = pk2(b[0], b[1]); w.w = pk2(b[2], b[3]); *(u32x4*)dst = w; } };
struct FMk { bf16_t* MK; float* out;
    __device__ __forceinline__ float rowscale(int) const { return 1.f; }
    __device__ __forceinline__ void operator()(int row, int col, f32x4 v) const {
        u32x2 w; w.x = pk2(v[0], v[1]); w.y = pk2(v[2], v[3]); *(u32x2*)(MK + (size_t)row * D + col) = w; __builtin_nontemporal_store(v, (f32x4*)(out + (size_t)row * D + col)); } };
struct FMvt { bf16_t* MVt; float* out;
    __device__ __forceinline__ float rowscale(int) const { return 1.f; }
    __device__ __forceinline__ void operator()(int row, int col, f32x4 v) const {
        u32x2 w; w.x = pk2(v[0], v[1]); w.y = pk2(v[2], v[3]); *(u32x2*)(MVt + ((size_t)(col >> 8) * D + row) * 256 + (col & 255)) = w;
#pragma unroll
        for (int e = 0; e < 4; ++e) out[(size_t)(col + e) * D + row] = v[e]; } };
struct FPart { float* P; int ld;
    __device__ __forceinline__ float rowscale(int) const { return 1.f; }
    __device__ __forceinline__ void operator()(int row, int col, f32x4 v) const { *(f32x4*)(P + (size_t)row * ld + col) = v; } };
struct FRi { bf16_t* R; size_t plane;
    __device__ __forceinline__ float rowscale(int) const { return 1.f; }
    __device__ __forceinline__ void operator()(int row, int col, f32x4 v) const {
        const int h = col >> 8, isI = (col >> 7) & 1, ch = h * 128 + (col & 127); u32x2 w; w.x = pk2(v[0], v[1]); w.y = pk2(v[2], v[3]); *(u32x2*)(R + (size_t)isI * plane + (size_t)row * 1024 + ch) = w; }
    __device__ __forceinline__ void f8(int row, int col, f32x4 a, f32x4 b) const {
        const int h = col >> 8, isI = (col >> 7) & 1, ch = h * 128 + (col & 127); u32x4 w; w.x = pk2(a[0], a[1]); w.y = pk2(a[2], a[3]); w.z = pk2(b[0], b[1]); w.w = pk2(b[2], b[3]);
        *(u32x4*)(R + (size_t)isI * plane + (size_t)row * 1024 + ch) = w; } };
__device__ __forceinline__ f32x2 gate_one(float rp, float ip, float ba, float bx, float sp, float xc) {
    const float r = sigmoidf_(rp + ba), i = sigmoidf_(ip + bx);
    const float la = -8.f * r * sp;
    const float a = __expf(la);
    return (f32x2){a, sqrtf(fmaxf(1.f - a * a, 0.f)) * (i * xc)};
}
template <class G>
__device__ __forceinline__ void skinny_piece(const bf16_t* A, int lda, const bf16_t* Bt, int ldb, int Kc, int ncol0, int row0, const G& g, const int w, LAS float* red) {
    const int lane = lane_id(), fr = lane & 15, fq = lane >> 4;
    const int kw = Kc >> 3, wk = (w + (int)blockIdx.x) & 7;
    f32x4 acc[8][2];
#pragma unroll
    for (int r = 0; r < 8; ++r) { acc[r][0] = (f32x4){0.f, 0.f, 0.f, 0.f}; acc[r][1] = (f32x4){0.f, 0.f, 0.f, 0.f}; }
    const bf16_t* ap = A + (size_t)fr * lda + wk * kw + 8 * fq;
    const bf16_t* bp = Bt + (size_t)(ncol0 + fr) * ldb + wk * kw + 8 * fq;
#pragma unroll 4
    for (int k = 0; k < kw; k += 32) {
        const bf16x8 b0 = ld8(bp + k), b1 = ld8(bp + (size_t)16 * ldb + k);
#pragma unroll
        for (int r = 0; r < 8; ++r) { const bf16x8 a = ld8(ap + (size_t)(16 * r) * lda + k); acc[r][0] = MFMA16(b0, a, acc[r][0]); acc[r][1] = MFMA16(b1, a, acc[r][1]); }
    }
    __syncthreads();
#pragma unroll
    for (int r = 0; r < 8; ++r)
#pragma unroll
        for (int t = 0; t < 2; ++t) *(LAS f32x4*)(red + ((w * 16 + r * 2 + t) * 64 + lane) * 4) = acc[r][t];
    __syncthreads();
#pragma unroll
    for (int t = 0; t < 2; ++t) {
        f32x4 s = (f32x4){0.f, 0.f, 0.f, 0.f};
#pragma unroll
        for (int ww = 0; ww < 8; ++ww) s = s + *(const LAS f32x4*)(red + ((ww * 16 + w * 2 + t) * 64 + lane) * 4);
        g(row0 + 16 * w + fr, ncol0 + 16 * t + 4 * fq, s * g.rowscale(row0 + 16 * w + fr));
    }
}
template <class G>
__device__ __forceinline__ void skinny_gemm(const bf16_t* A, int lda, const bf16_t* Bt, int ldb, int K, int N, int ksplit, int cu0, int ncu, int row0, const G& g, int part_rows, const int w, LAS float* red) {
    const int me = (int)blockIdx.x - cu0; if (me < 0 || me >= ncu) return;
    const int nsl = N / 32, np = nsl * ksplit, Kc = K / ksplit;
    for (int p = me; p < np; p += ncu) {
        const int sl = p % nsl, ks = p / nsl;
        skinny_piece(A + (size_t)ks * Kc, lda, Bt + (size_t)ks * Kc, ldb, Kc, 32 * sl, row0 + ks * part_rows, g, w, red);
    }
}
#define XB_TMO      128
#define XB_XCNT(j)  (256  + 64 * (j))
#define XB_XSUB(j)  (1280 + 64 * (j))
#define XB_XGEN(j)  (2304 + 64 * (j))
#define XB_TOP      3328
#define XB_TOPGEN   3392
#define XCD_BAR_WORDS 3456
#define XB_SPIN_CAP (1u << 18)
__device__ __forceinline__ unsigned xb_ld(unsigned* p)              { return __hip_atomic_load(p, __ATOMIC_RELAXED, __HIP_MEMORY_SCOPE_AGENT); }
__device__ __forceinline__ unsigned xb_add(unsigned* p, unsigned v) { return __hip_atomic_fetch_add(p, v, __ATOMIC_RELAXED, __HIP_MEMORY_SCOPE_AGENT); }
__device__ __forceinline__ unsigned xb_xcc_id() { return (unsigned)__builtin_amdgcn_s_getreg((3 << 11) | 20) & 0xFu; }
#define XB_SPIN(cond, bar) do { unsigned _sp = 0; while (cond) { __builtin_amdgcn_s_sleep(1); \
    if ((++_sp & 255u) == 0u) { if (xb_ld(&(bar)[XB_TMO])) break; if (_sp > XB_SPIN_CAP) { atomicAdd(&(bar)[XB_TMO], 1u); break; } } } } while (0)
struct XcdBarrier { unsigned* bar; unsigned x; volatile LAS unsigned* st; };
__device__ __forceinline__ void xcd_barrier_complete(unsigned* bar, unsigned x, unsigned& nloc, unsigned& nx) {
    const unsigned G = gridDim.x * gridDim.y * gridDim.z;
    unsigned sum, cnt, mine, sp = 0u;
    for (;;) {
        sum = 0u; cnt = 0u; mine = 0u;
#pragma unroll
        for (unsigned j = 0; j < 16; ++j) { const unsigned c = xb_ld(&bar[XB_XCNT(j)]); sum += c; cnt += (c > 0u) ? 1u : 0u; mine = (j == x) ? c : mine; }
        if (sum == G) break;
        __builtin_amdgcn_s_sleep(1);
        if ((++sp & 255u) == 0u) { if (xb_ld(&bar[XB_TMO])) break; if (sp > XB_SPIN_CAP) { atomicAdd(&bar[XB_TMO], 1u); break; } }
    }
    nloc = mine > 0u ? mine : 1u; nx = cnt > 0u ? cnt : 1u;
}
__device__ __forceinline__ void xcd_barrier(const XcdBarrier& b, const int wave) {
    asm volatile("s_waitcnt vmcnt(0)" ::: "memory");
    __syncthreads();
    if (wave == 0 && lane_id() == 0) {
        unsigned* bar = b.bar;
        __builtin_amdgcn_s_waitcnt(0);
        unsigned nloc = b.st[0], nx = b.st[1];
        if (nloc == 0u) { xcd_barrier_complete(bar, b.x, nloc, nx); b.st[0] = nloc; b.st[1] = nx; }
        const unsigned old = xb_add(&bar[XB_XSUB(b.x)], 1u);
        const unsigned gen = old / nloc;
        if (old + 1u == (gen + 1u) * nloc) {
            __builtin_amdgcn_fence(__ATOMIC_RELEASE, "agent");
            asm volatile("s_waitcnt vmcnt(0)" ::: "memory");
            const unsigned og = xb_add(&bar[XB_TOP], 1u);
            const unsigned tg = og / nx;
            if (og + 1u == (tg + 1u) * nx) xb_add(&bar[XB_TOPGEN], 1u);
            else XB_SPIN(xb_ld(&bar[XB_TOPGEN]) == tg, bar);
            __builtin_amdgcn_fence(__ATOMIC_ACQUIRE, "agent");
            xb_add(&bar[XB_XGEN(b.x)], 1u);
            asm volatile("s_waitcnt vmcnt(0)" ::: "memory");
        } else {
            XB_SPIN(xb_ld(&bar[XB_XGEN(b.x)]) == gen, bar);
            __builtin_amdgcn_fence(__ATOMIC_ACQUIRE, "agent");
            asm volatile("s_waitcnt vmcnt(0)" ::: "memory");
        }
    }
    __syncthreads();
}

struct Args { const float* in[39]; float* out; unsigned char* ws; int ph_lo, ph_hi; };
enum { I_XP = 0, I_XS, I_MEM, I_SRH, I_SRC, I_SMC_, I_SMN, I_SMM, I_SMCV, I_CK, I_CV, I_GMIX, I_WIN, I_CRW, I_CRB, I_WA, I_BA, I_WX, I_BX, I_LAM, I_GRNN,
       I_CMW, I_CMB, I_WQ, I_WK, I_BI, I_BF, I_GML, I_WOUT, I_GX, I_GMEM, I_WCQ, I_WMK, I_WMV, I_WCO, I_GFFN, I_WUP, I_WDN, I_GFIN };

__device__ __forceinline__ void transpose_item(const float* W, int ldw, bf16_t* WT, int ldt, LAS float* scr, int kb, int nb, int lane) {
    const int k0 = 64 * kb, n0 = 32 * nb;
    f32x4 ld[8];
#pragma unroll
    for (int i = 0; i < 8; ++i) ld[i] = __builtin_nontemporal_load((const f32x4*)(W + (size_t)(k0 + 8 * i + (lane >> 3)) * ldw + n0 + 4 * (lane & 7)));
#pragma unroll
    for (int i = 0; i < 8; ++i) { LAS float* d = scr + (8 * i + (lane >> 3)) * 33 + 4 * (lane & 7); d[0] = ld[i][0]; d[1] = ld[i][1]; d[2] = ld[i][2]; d[3] = ld[i][3]; }
    asm volatile("s_waitcnt lgkmcnt(0)" ::: "memory");
    const int c = lane & 7;
#pragma unroll
    for (int j = 0; j < 4; ++j) { const int n = (lane >> 3) + 8 * j; const LAS float* s = scr + (8 * c) * 33 + n;
        u32x4 o; o.x = pk2(s[0 * 33], s[1 * 33]); o.y = pk2(s[2 * 33], s[3 * 33]); o.z = pk2(s[4 * 33], s[5 * 33]); o.w = pk2(s[6 * 33], s[7 * 33]);
        *(u32x4*)(WT + (size_t)(n0 + n) * ldt + k0 + 8 * c) = o; }
    asm volatile("s_waitcnt lgkmcnt(0)" ::: "memory");
}
__device__ __forceinline__ void convert_matrix(const float* W, int ldw, int K, int N, bf16_t* WT, int ldt, LAS float* scr, int gw_, int ngw_, int lane) {
    const int nb = N / 32, items = (K / 64) * nb;
    for (int it = gw_; it < items; it += ngw_) transpose_item(W, ldw, WT, ldt, scr, it / nb, it % nb, lane);
}
__device__ __forceinline__ void load_gain(const float* g, int lane, f32x4 (&gg)[8]) {
#pragma unroll
    for (int j = 0; j < 8; ++j) gg[j] = *(const f32x4*)(g + 256 * j + 4 * lane);
}
__device__ __forceinline__ void norm_row(const float* xrow, const f32x4 (&gg)[8], bf16_t* orow, int lane) {
    f32x4 v[8]; float ss = 0.f;
#pragma unroll
    for (int j = 0; j < 8; ++j) { v[j] = __builtin_nontemporal_load((const f32x4*)(xrow + 256 * j + 4 * lane)); ss += (v[j][0] * v[j][0] + v[j][1] * v[j][1]) + (v[j][2] * v[j][2] + v[j][3] * v[j][3]); }
    const float rstd = rsqrtf(wave_sum(ss) * (1.f / D) + EPS);
#pragma unroll
    for (int j = 0; j < 8; ++j) { const f32x4 a = v[j] * rstd * gg[j]; u32x2 w; w.x = pk2(a[0], a[1]); w.y = pk2(a[2], a[3]); *(u32x2*)(orow + 256 * j + 4 * lane) = w; }
}

#define wsWinT ((bf16_t*)(ws + WS_WIN2))
#define wsWoutT ((bf16_t*)(ws + WS_WOUT))
#define wsWcqT ((bf16_t*)(ws + WS_WCQ))
#define wsWmkT ((bf16_t*)(ws + WS_WMK))
#define wsWmvT ((bf16_t*)(ws + WS_WMV))
#define wsWcoT ((bf16_t*)(ws + WS_WCO))
#define wsWupT ((bf16_t*)(ws + WS_WUP))
#define wsWdnT ((bf16_t*)(ws + WS_WDN))
#define wsWgT ((bf16_t*)(ws + WS_WG))
#define wsWqkT ((bf16_t*)(ws + WS_WQK))
#define wsXN ((bf16_t*)(ws + WS_XN))
#define wsMN ((bf16_t*)(ws + WS_MN))
#define wsZ ((bf16_t*)(ws + WS_Z))
#define wsGATES ((float*)(ws + WS_GATES))
#define wsXC ((bf16_t*)(ws + WS_XC))
#define wsUC ((bf16_t*)(ws + WS_UC))
#define wsAU ((bf16_t*)(ws + WS_AU))
#define wsQm ((bf16_t*)(ws + WS_QM))
#define wsKm ((bf16_t*)(ws + WS_KM))
#define wsY ((bf16_t*)(ws + WS_Y))
#define wsX1 ((bf16_t*)(ws + WS_X1))
#define wsX2 ((bf16_t*)(ws + WS_X2))
#define wsQC ((bf16_t*)(ws + WS_QC))
#define wsOC ((bf16_t*)(ws + WS_OC))
#define wsMK ((bf16_t*)(ws + WS_MK))
#define wsMVt ((bf16_t*)(ws + WS_MVT))
#define wsVW ((bf16_t*)(ws + WS_Y))
#define wsU ((bf16_t*)(ws + WS_U))
#define wsCLOC ((bf16_t*)(ws + WS_CLOC))
#define wsCIN ((bf16_t*)(ws + WS_CIN))
#define wsNLOC ((float*)(ws + WS_NLOC))
#define wsNIN ((float*)(ws + WS_NIN))
#define wsMSTAT ((float*)(ws + WS_MSTAT))
#define wsMINB (wsMSTAT + 1024)
#define wsSUM ((float*)(ws + WS_SUM))
#define wsPART ((float*)(ws + WS_PART))
#define wsSPL (wsMSTAT + 4096)
#define wsSS (wsMSTAT + 8192)
#define wsPB ((bf16_t*)(ws + WS_U))
__global__ void __launch_bounds__(512, 2) mega_fwd(Args args) {
    extern __shared__ __attribute__((aligned(16))) unsigned char lds_raw[];
    LAS unsigned char* lds = (LAS unsigned char*)lds_raw;
    LAS float* misc = (LAS float*)(lds + MISC_OFF);
    const int wave = __builtin_amdgcn_readfirstlane((int)threadIdx.x >> 6);
    const int G = gridDim.x, bid = blockIdx.x;
    const int NGW = G * 8, NGT = G * 512;
#define PH_IDS const int lane = lane_id(); const int tid = wave * 64 + lane; const int gw = bid * 8 + wave; const int gt = bid * 512 + tid; (void)gw; (void)gt; (void)lane; (void)tid;
    unsigned char* ws = args.ws;
    float* out = args.out;
    volatile LAS unsigned* bst = (volatile LAS unsigned*)(lds + LDS_BYTES - 16);
    if (wave == 0 && lane_id() == 0) { bst[0] = 0u; bst[1] = 0u; }
    __syncthreads();
    XcdBarrier xbar; xbar.bar = (unsigned*)(ws + WS_CTL); xbar.x = xb_xcc_id(); xbar.st = bst;
    if (wave == 0 && lane_id() == 0) (void)xb_add(&xbar.bar[XB_XCNT(xbar.x)], 1u);
    const int lo = args.ph_lo, hi = args.ph_hi;
#ifndef PH_MASK
#define PH_MASK 0xFFFF
#endif
#define IN(k) (((PH_MASK >> (k)) & 1) && lo <= (k) && (k) < hi)
#ifndef DUP_MASK
#define DUP_MASK 0
#endif
#define REP(k) for (int rep_ = 0; rep_ <= ((DUP_MASK >> (k)) & 1); ++rep_)
#ifndef DUP_BAR
#define DUP_BAR 0
#endif
#define SEAM(k) do { if (IN(k)) { xcd_barrier(xbar, wave); if (DUP_BAR) { xcd_barrier(xbar, wave); xcd_barrier(xbar, wave); } } } while (0)

    REP(0) if (IN(0)) { PH_IDS
        LAS float* scr = (LAS float*)(lds + wave * 16384);
        constexpr int I_A = 32 * 160, I_S = 32 * 64, NIT = I_A + 3 * I_S;
        for (int it = gw; it < NIT; it += NGW) {
            int r = it;
            if (r < I_A) { transpose_item(args.in[I_WIN], DIN, wsWinT, D, scr, r / 160, r % 160, lane); continue; } r -= I_A;
            if (r < I_S) { transpose_item(args.in[I_WOUT], D, wsWoutT, D, scr, r / 64, r % 64, lane); continue; } r -= I_S;
            if (r < I_S) { transpose_item(args.in[I_WMK], D, wsWmkT, D, scr, r / 64, r % 64, lane); continue; } r -= I_S;
            transpose_item(args.in[I_WMV], D, wsWmvT, D, scr, r / 64, r % 64, lane);
        }
        for (int idx = gt; idx < 8 * 256 * 256; idx += NGT) {
            const int h = idx >> 16, j = (idx >> 8) & 255, k = idx & 255, kk = k - (h & 1) * 128;
            float v = 0.f;
            if (kk >= 0 && kk < 128) v = (j < 128) ? args.in[I_WA][((size_t)h * 128 + kk) * 128 + j] : args.in[I_WX][((size_t)h * 128 + kk) * 128 + (j - 128)];
            wsWgT[idx] = (bf16_t)f2bf(v);
        }
        for (int idx = gt; idx < 4 * 512 * 256; idx += NGT) {
            const int h = idx >> 17, j = (idx >> 8) & 511, k = idx & 255;
            const float v = (j < 256) ? args.in[I_WQ][((size_t)h * 256 + k) * 256 + j] : args.in[I_WK][((size_t)h * 256 + k) * 256 + (j - 256)] * 0.0625f;
            wsWqkT[idx] = (bf16_t)f2bf(v);
        }
        for (int idx = gt; idx < 2 * MT; idx += NGT) wsSS[idx] = 0.f;
        for (int idx = gt; idx < 1024; idx += NGT) { const float l = args.in[I_LAM][idx]; wsSPL[idx] = fmaxf(-l, 0.f) + log1pf(__expf(-fabsf(l))); }
        for (int idx = gt; idx < 8 * 2048; idx += NGT) { const int c = idx >> 11, k = idx & 2047; wsWinT[(size_t)(NZ + c) * D + k] = (bf16_t)f2bf(args.in[I_WIN][(size_t)k * DIN + NZ + c]); }
        { f32x4 gg[8]; load_gain(args.in[I_GMIX], lane, gg);
          for (int m = gw; m < MT; m += NGW) { const float* xrow = m < MP ? args.in[I_XP] + (size_t)m * D : args.in[I_XS] + (size_t)(m - MP) * D; norm_row(xrow, gg, wsXN + (size_t)m * D, lane); } }
        { f32x4 gg[8]; load_gain(args.in[I_GMEM], lane, gg);
          for (int m = gw; m < MMEM; m += NGW) norm_row(args.in[I_MEM] + (size_t)m * D, gg, wsMN + (size_t)m * D, lane); }
        __syncthreads();
    }
    SEAM(0);

    REP(1) if (IN(1)) { PH_IDS
        { const pg8::Gemm g = pg8::mk_gemm(wsXN, wsWinT, D * 2, D * 2, D, 0); pg8::StaticOrder S; S.init(33, 21, G, bid);
          pg8::EpiF8<FZ> E{{wsZ, wsGATES}}; pg8::gemm_phase<pg8::EpiF8<FZ>, true, true>(lds, g, S, E, wave); }
        { const pg8::Gemm g = pg8::mk_gemm(wsMN, wsWmkT, D * 2, D * 2, D, 0); pg8::StaticOrder S; S.init(4, 8, G, G - 1 - bid);
          pg8::EpiF<FMk> E{{wsMK, out + O_PK}}; pg8::gemm_phase<pg8::EpiF<FMk>, true, true>(lds, g, S, E, wave); }
        { const pg8::Gemm g = pg8::mk_gemm(wsMN, wsWmvT, D * 2, D * 2, D, 0); pg8::StaticOrder S; S.init(4, 8, G, G - 33 - bid);
          pg8::EpiF<FMk> E{{wsMVt, out + O_PV}}; pg8::gemm_phase<pg8::EpiF<FMk>, true, true>(lds, g, S, E, wave); }
    }
    SEAM(1);

    REP(2) if (IN(2)) { PH_IDS
        const int gi = gt & 255, which = gi >> 7, c0 = (gi & 127) * 8, zc = (which ? OFF_MU : OFF_RX) + c0;
        const float* cw = args.in[which ? I_CMW : I_CRW]; const float* cb = args.in[which ? I_CMB : I_CRB];
        float wt[4][8], wb[8];
#pragma unroll
        for (int e = 0; e < 8; ++e) { wb[e] = cb[c0 + e];
#pragma unroll
            for (int j = 0; j < 4; ++j) wt[j][e] = cw[j * 1024 + c0 + e]; }
        for (int m = gt >> 8; m < MT; m += NGT >> 8) {
            float x[4][8];
            if (m < MP) {
                const int t = m & (TT - 1);
#pragma unroll
                for (int j = 0; j < 4; ++j) {
                    if (t - 3 + j >= 0) { const u32x4 w = *(const u32x4*)(wsZ + (size_t)(m - 3 + j) * NZ + zc);
                        x[j][0] = bflo(w.x); x[j][1] = bfhi(w.x); x[j][2] = bflo(w.y); x[j][3] = bfhi(w.y); x[j][4] = bflo(w.z); x[j][5] = bfhi(w.z); x[j][6] = bflo(w.w); x[j][7] = bfhi(w.w); }
                    else {
#pragma unroll
                        for (int e = 0; e < 8; ++e) x[j][e] = 0.f; }
                }
                if (t >= TT - 3) { float* o = out + (which ? O_PMC : O_PRC) + ((size_t)(m >> 11) * 3 + (t - (TT - 3))) * 1024 + c0;
                    *(f32x4*)o = (f32x4){x[3][0], x[3][1], x[3][2], x[3][3]}; *(f32x4*)(o + 4) = (f32x4){x[3][4], x[3][5], x[3][6], x[3][7]}; }
            } else {
                const int sb = m - MP; const float* st = args.in[which ? I_SMCV : I_SRC] + (size_t)sb * 3 * 1024 + c0;
#pragma unroll
                for (int j = 0; j < 3; ++j) { const f32x4 a = *(const f32x4*)(st + j * 1024), b = *(const f32x4*)(st + j * 1024 + 4);
                    x[j][0] = a[0]; x[j][1] = a[1]; x[j][2] = a[2]; x[j][3] = a[3]; x[j][4] = b[0]; x[j][5] = b[1]; x[j][6] = b[2]; x[j][7] = b[3]; }
                const u32x4 w = *(const u32x4*)(wsZ + (size_t)m * NZ + zc);
                x[3][0] = bflo(w.x); x[3][1] = bfhi(w.x); x[3][2] = bflo(w.y); x[3][3] = bfhi(w.y); x[3][4] = bflo(w.z); x[3][5] = bfhi(w.z); x[3][6] = bflo(w.w); x[3][7] = bfhi(w.w);
                float* o = out + (which ? O_SMC : O_SRC) + (size_t)sb * 3 * 1024 + c0;
#pragma unroll
                for (int j = 0; j < 3; ++j) { *(f32x4*)(o + j * 1024) = (f32x4){x[j + 1][0], x[j + 1][1], x[j + 1][2], x[j + 1][3]}; *(f32x4*)(o + j * 1024 + 4) = (f32x4){x[j + 1][4], x[j + 1][5], x[j + 1][6], x[j + 1][7]}; }
            }
            float y[8];
#pragma unroll
            for (int e = 0; e < 8; ++e) y[e] = wb[e];
#pragma unroll
            for (int j = 0; j < 4; ++j)
#pragma unroll
                for (int e = 0; e < 8; ++e) y[e] += wt[j][e] * x[j][e];
            if (which) {
#pragma unroll
                for (int e = 0; e < 8; ++e) y[e] = y[e] * sigmoidf_(y[e]);
            }
            u32x4 w; w.x = pk2(y[0], y[1]); w.y = pk2(y[2], y[3]); w.z = pk2(y[4], y[5]); w.w = pk2(y[6], y[7]);
            *(u32x4*)((which ? wsUC : wsXC) + (size_t)m * 1024 + c0) = w;
        }
    }
    SEAM(2);

    REP(3) if (IN(3)) { PH_IDS
        { const pg8::Gemm g = pg8::mk_gemm(wsXC, wsWgT, 2048, 512, 256, 512); pg8::StaticOrder S; S.init(32, 8, G, bid);
          pg8::EpiF8<FRi> E{{wsAU, (size_t)MT * 1024}}; pg8::gemm_phase<pg8::EpiF8<FRi>, true, true>(lds, g, S, E, wave); }
        { const pg8::Gemm g = pg8::mk_gemm(wsUC, wsWqkT, 2048, 512, 256, 512); pg8::StaticOrder S; S.init(32, 8, G, bid);
          pg8::EpiF8<FQkSplit> E{{wsQm, (WS_KM - WS_QM) / 2}}; pg8::gemm_phase<pg8::EpiF8<FQkSplit>, true, true>(lds, g, S, E, wave); }
        if (bid < 64) { const int h = bid >> 3;
            skinny_piece(wsXC + (size_t)MP * 1024 + 256 * (h >> 1), 1024, wsWgT, 256, 256, 32 * bid, MP, FRi{wsAU, (size_t)MT * 1024}, wave, (LAS float*)lds); }
        else if (bid < 128) { const int p = bid - 64; const int hh = p >> 4;
            skinny_piece(wsUC + (size_t)MP * 1024 + 256 * hh, 1024, wsWqkT, 256, 256, 32 * p, MP, FQkSplit{wsQm, (WS_KM - WS_QM) / 2}, wave, (LAS float*)lds); }
    }
    SEAM(3);

    REP(4) if (IN(4)) { PH_IDS
        for (int u = bid; u < 256; u += G) {
            const int m0 = (u >> 6) * TT + (u & 63) * 32;
            float A0 = 1.f, A1 = 1.f, h0 = 0.f, h1 = 0.f;
            const f32x2 ba = *(const f32x2*)(args.in[I_BA] + 2 * tid), bx = *(const f32x2*)(args.in[I_BX] + 2 * tid), sp = *(const f32x2*)(wsSPL + 2 * tid);
#pragma unroll 8
            for (int i = 0; i < 32; ++i) { const size_t o = (size_t)(m0 + i) * 1024 + 2 * tid;
                const unsigned rw_ = *(const unsigned*)(wsAU + o), iw_ = *(const unsigned*)(wsAU + (size_t)MT * 1024 + o); const f32x2 rp = (f32x2){bflo(rw_), bfhi(rw_)}, ip = (f32x2){bflo(iw_), bfhi(iw_)}; const unsigned xw = *(const unsigned*)(wsXC + o);
                const f32x2 g0 = gate_one(rp[0], ip[0], ba[0], bx[0], sp[0], bflo(xw)), g1 = gate_one(rp[1], ip[1], ba[1], bx[1], sp[1], bfhi(xw));
                h0 = g0[0] * h0 + g0[1]; A0 *= g0[0]; h1 = g1[0] * h1 + g1[1]; A1 *= g1[0]; }
            *(f32x4*)(wsSUM + ((size_t)u * 1024 + 2 * tid) * 2) = (f32x4){A0, h0, A1, h1};
        }
        for (int u = bid; u < 256; u += G) {
            const int bh = u >> 4, c = u & 15, b = bh >> 2, h = bh & 3, m0 = b * TT + c * 128;
            LAS float* ic = misc; LAS float* bb = misc + 128; LAS float* wv = misc + 256; LAS float* sc = misc + 384;
            __syncthreads();
            if (tid < 128) { ic[tid] = wsGATES[(size_t)(m0 + tid) * 8 + h] + args.in[I_BI][h]; bb[tid] = logsigmoid_(wsGATES[(size_t)(m0 + tid) * 8 + 4 + h] + args.in[I_BF][h]); }
            __syncthreads();
            if (wave == 0) {
                const float x0 = bb[2 * lane], x1 = bb[2 * lane + 1], loc = x0 + x1; float inc = loc;
#pragma unroll
                for (int o = 1; o < 64; o <<= 1) { const float t = __shfl_up(inc, o); if (lane >= o) inc += t; }
                const float b0 = inc - x1, b1 = inc, a = __shfl(inc, 63);
                const float mx = wave_max(fmaxf(ic[2 * lane] + a - b0, ic[2 * lane + 1] + a - b1));
                bb[2 * lane] = b0; bb[2 * lane + 1] = b1;
                if (lane == 0) { sc[0] = mx; sc[1] = a; wsMSTAT[u * 2] = mx; wsMSTAT[u * 2 + 1] = a; }
            }
            __syncthreads();
            if (tid < 128) wv[tid] = __expf(ic[tid] + sc[1] - bb[tid] - sc[0]);
            __syncthreads();
            LAS unsigned char* VTl = lds; LAS unsigned char* KTl = lds + 67584;
            for (int idx = tid; idx < 128 * 32; idx += 512) {
                const int s = idx >> 5, ch = idx & 31; const float w = wv[s];
                const u32x4 v = *(const u32x4*)(wsZ + (size_t)(m0 + s) * NZ + OFF_MV + h * 256 + ch * 8);
                u32x4 o; o.x = pk2(bflo(v.x) * w, bfhi(v.x) * w); o.y = pk2(bflo(v.y) * w, bfhi(v.y) * w); o.z = pk2(bflo(v.z) * w, bfhi(v.z) * w); o.w = pk2(bflo(v.w) * w, bfhi(v.w) * w);
                *(LAS u32x4*)(VTl + s * 528 + ch * 16) = o;
                *(LAS u32x4*)(KTl + s * 528 + ch * 16) = *(const u32x4*)(wsKm + (size_t)(m0 + s) * 1024 + h * 256 + ch * 8);
            }
            __syncthreads();
            {
                const int g4 = lane >> 4, q = (lane & 15) >> 2, p = lane & 3;
                f32x4 acc[2][16];
#pragma unroll
                for (int a = 0; a < 2; ++a)
#pragma unroll
                    for (int k = 0; k < 16; ++k) acc[a][k] = (f32x4){0.f, 0.f, 0.f, 0.f};
                for (int ks = 0; ks < 4; ++ks) {
                    const int rb = (32 * ks + 8 * g4 + q) * 528 + 8 * p;
                    bf16x8 yv[2];
#pragma unroll
                    for (int a = 0; a < 2; ++a) yv[a] = cat8(tr_read(VTl + rb + (32 * wave + 16 * a) * 2), tr_read(VTl + rb + 4 * 528 + (32 * wave + 16 * a) * 2));
#pragma unroll
                    for (int kt = 0; kt < 16; ++kt) {
                        const bf16x8 xk = cat8(tr_read(KTl + rb + 32 * kt), tr_read(KTl + rb + 4 * 528 + 32 * kt));
                        acc[0][kt] = MFMA16(xk, yv[0], acc[0][kt]); acc[1][kt] = MFMA16(xk, yv[1], acc[1][kt]);
                    }
                }
#pragma unroll
                for (int a = 0; a < 2; ++a)
#pragma unroll
                    for (int kt = 0; kt < 16; ++kt) { u32x2 w; w.x = pk2(acc[a][kt][0], acc[a][kt][1]); w.y = pk2(acc[a][kt][2], acc[a][kt][3]);
                        *(u32x2*)(wsCLOC + (size_t)u * 65536 + (size_t)(32 * wave + 16 * a + (lane & 15)) * 256 + 16 * kt + 4 * g4) = w; }
            }
            if (tid < 256) { float s = 0.f; for (int i = 0; i < 128; ++i) s += wv[i] * bf2f(*(const LAS bf16_t*)(KTl + i * 528 + tid * 2)); wsNLOC[(size_t)u * 256 + tid] = s; }
            __syncthreads();
        }
    }
    SEAM(4);

    REP(5) if (IN(5)) { PH_IDS
        for (int st_ = 0; st_ < 3; ++st_) { const int which = (bid & 1) ? (st_ + 2) % 3 : st_;
        __syncthreads();
        if (which == 0) for (int u = bid; u < 288; u += G) {
            LAS float* tile = (LAS float*)lds;
            __syncthreads();
            if (u < 256) {
                const int b = u >> 6, ch = u & 63, m0 = b * TT + ch * 32;
                float h0 = 0.f, h1 = 0.f;
                const f32x2 ba = *(const f32x2*)(args.in[I_BA] + 2 * tid), bx = *(const f32x2*)(args.in[I_BX] + 2 * tid), sp = *(const f32x2*)(wsSPL + 2 * tid);
#pragma unroll 8
                for (int cc = 0; cc < ch; ++cc) { const f32x4 q = *(const f32x4*)(wsSUM + ((size_t)(b * 64 + cc) * 1024 + 2 * tid) * 2); h0 = q[0] * h0 + q[1]; h1 = q[2] * h1 + q[3]; }
#pragma unroll 8
                for (int i = 0; i < 32; ++i) {
                    const size_t o = (size_t)(m0 + i) * 1024 + 2 * tid;
                    const unsigned rw_ = *(const unsigned*)(wsAU + o), iw_ = *(const unsigned*)(wsAU + (size_t)MT * 1024 + o); const f32x2 rp = (f32x2){bflo(rw_), bfhi(rw_)}, ip = (f32x2){bflo(iw_), bfhi(iw_)}; const unsigned xw = *(const unsigned*)(wsXC + o);
                    const f32x2 g0 = gate_one(rp[0], ip[0], ba[0], bx[0], sp[0], bflo(xw)), g1 = gate_one(rp[1], ip[1], ba[1], bx[1], sp[1], bfhi(xw));
                    h0 = g0[0] * h0 + g0[1]; h1 = g1[0] * h1 + g1[1];
                    const unsigned gr = *(const unsigned*)(wsZ + (size_t)(m0 + i) * NZ + OFF_RG + 2 * tid);
                    *(LAS f32x2*)(tile + i * 1024 + 2 * tid) = (f32x2){h0 * gelu_tanh(bflo(gr)), h1 * gelu_tanh(bfhi(gr))};
                }
                if (ch == 63) *(f32x2*)(out + O_PH + (size_t)b * 1024 + 2 * tid) = (f32x2){h0, h1};
            } else {
                const int sb0 = (u - 256) * 4;
                const f32x2 ba = *(const f32x2*)(args.in[I_BA] + 2 * tid), bx = *(const f32x2*)(args.in[I_BX] + 2 * tid), sp = *(const f32x2*)(wsSPL + 2 * tid);
#pragma unroll
                for (int i = 0; i < 4; ++i) {
                    const int sb = sb0 + i, m = MP + sb;
                    const size_t o = (size_t)m * 1024 + 2 * tid;
                    const unsigned rw_ = *(const unsigned*)(wsAU + o), iw_ = *(const unsigned*)(wsAU + (size_t)MT * 1024 + o); const f32x2 rp = (f32x2){bflo(rw_), bfhi(rw_)}, ip = (f32x2){bflo(iw_), bfhi(iw_)}; const unsigned xw = *(const unsigned*)(wsXC + o);
                    const f32x2 g0 = gate_one(rp[0], ip[0], ba[0], bx[0], sp[0], bflo(xw)), g1 = gate_one(rp[1], ip[1], ba[1], bx[1], sp[1], bfhi(xw));
                    const f32x2 hp = *(const f32x2*)(args.in[I_SRH] + (size_t)sb * 1024 + 2 * tid);
                    const float h0 = g0[0] * hp[0] + g0[1], h1 = g1[0] * hp[1] + g1[1];
                    *(f32x2*)(out + O_SH + (size_t)sb * 1024 + 2 * tid) = (f32x2){h0, h1};
                    const unsigned gr = *(const unsigned*)(wsZ + (size_t)m * NZ + OFF_RG + 2 * tid);
                    *(LAS f32x2*)(tile + i * 1024 + 2 * tid) = (f32x2){h0 * gelu_tanh(bflo(gr)), h1 * gelu_tanh(bfhi(gr))};
                }
            }
            __syncthreads();
            const int mrow0 = (u < 256) ? ((u >> 6) * TT + (u & 63) * 32) : (MP + (u - 256) * 4);
            const int nrows = (u < 256) ? 32 : 4;
#pragma unroll
            for (int r = 0; r < 4; ++r) {
                const int i = wave * 4 + r; if (i >= nrows) continue; f32x4 v[4]; float ss = 0.f;
#pragma unroll
                for (int j = 0; j < 4; ++j) { v[j] = *(const LAS f32x4*)(tile + i * 1024 + 256 * j + 4 * lane); ss += (v[j][0] * v[j][0] + v[j][1] * v[j][1]) + (v[j][2] * v[j][2] + v[j][3] * v[j][3]); }
                const float rstd = rsqrtf(wave_sum(ss) * (1.f / 1024.f) + EPS);
#pragma unroll
                for (int j = 0; j < 4; ++j) { const f32x4 gg = *(const f32x4*)(args.in[I_GRNN] + 256 * j + 4 * lane); const f32x4 o = v[j] * rstd * gg;
                    u32x2 w; w.x = pk2(o[0], o[1]); w.y = pk2(o[2], o[3]); *(u32x2*)(wsY + (size_t)(mrow0 + i) * D + 256 * j + 4 * lane) = w; }
            }
        }
        if (which == 1) for (int u = bid; u < 256; u += G) {
            const int bh = u >> 4, sl = u & 15, v = 16 * sl + (tid >> 5), k0 = (tid & 31) * 8;
            float cs[8];
#pragma unroll
            for (int e = 0; e < 8; ++e) cs[e] = 0.f;
            float m = 0.f, ns = 0.f;
#pragma unroll
            for (int c = 0; c < 16; ++c) {
                const int cu = bh * 16 + c; const float mloc = wsMSTAT[cu * 2], bL = wsMSTAT[cu * 2 + 1];
                const float mn = fmaxf(bL + m, mloc), al = __expf(bL + m - mn), be = __expf(mloc - mn);
                u32x4 w; w.x = pk2(cs[0], cs[1]); w.y = pk2(cs[2], cs[3]); w.z = pk2(cs[4], cs[5]); w.w = pk2(cs[6], cs[7]);
                *(u32x4*)(wsCIN + (size_t)cu * 65536 + (size_t)v * 256 + k0) = w;
                const u32x4 l = *(const u32x4*)(wsCLOC + (size_t)cu * 65536 + (size_t)v * 256 + k0);
                cs[0] = al * cs[0] + be * bflo(l.x); cs[1] = al * cs[1] + be * bfhi(l.x); cs[2] = al * cs[2] + be * bflo(l.y); cs[3] = al * cs[3] + be * bfhi(l.y);
                cs[4] = al * cs[4] + be * bflo(l.z); cs[5] = al * cs[5] + be * bfhi(l.z); cs[6] = al * cs[6] + be * bflo(l.w); cs[7] = al * cs[7] + be * bfhi(l.w);
                if (sl == 0 && tid < 256) { wsNIN[(size_t)cu * 256 + tid] = ns; ns = al * ns + be * wsNLOC[(size_t)cu * 256 + tid]; }
                if (sl == 0 && tid == 0) wsMINB[cu] = m;
                m = mn;
            }
            float* oc = out + O_PC + (size_t)bh * 65536 + (size_t)v * 256 + k0;
            *(f32x4*)oc = (f32x4){cs[0], cs[1], cs[2], cs[3]}; *(f32x4*)(oc + 4) = (f32x4){cs[4], cs[5], cs[6], cs[7]};
            if (sl == 0 && tid < 256) out[O_PN + (size_t)bh * 256 + tid] = ns;
            if (sl == 0 && tid == 0) out[O_PM + bh] = m;
        }
        if (which == 2) for (int u = bid; u < 512; u += G) {
            const int sb = u >> 2, h = u & 3, m = MP + sb;
            LAS float* red = misc;
            LAS float* hv = misc + 16;
            __syncthreads();
            const float ig = wsGATES[(size_t)m * 8 + h] + args.in[I_BI][h], lf = logsigmoid_(wsGATES[(size_t)m * 8 + 4 + h] + args.in[I_BF][h]);
            const float mp = args.in[I_SMM][sb * 4 + h];
            const float inter = lf + mp, mt = fmaxf(inter, ig), wi = __expf(inter - mt), sd = __expf(ig - mt);
            const u32x2 qw = *(const u32x2*)(wsQm + (size_t)m * 1024 + h * 256 + 4 * lane), kw = *(const u32x2*)(wsKm + (size_t)m * 1024 + h * 256 + 4 * lane);
            const f32x4 qv = (f32x4){bflo(qw.x), bfhi(qw.x), bflo(qw.y), bfhi(qw.y)}, kv = (f32x4){bflo(kw.x), bfhi(kw.x), bflo(kw.y), bfhi(kw.y)};
            const f32x4 nv = *(const f32x4*)(args.in[I_SMN] + (size_t)u * 256 + 4 * lane);
            const float qk = wave_sum((qv[0] * kv[0] + qv[1] * kv[1]) + (qv[2] * kv[2] + qv[3] * kv[3]));
            const float nq = wave_sum((qv[0] * nv[0] + qv[1] * nv[1]) + (qv[2] * nv[2] + qv[3] * nv[3]));
            const float s = qk * sd, den = wi * nq + s, dn = fmaxf(fabsf(den), __expf(-mt));
            if (wave == 0) { *(f32x4*)(out + O_SN + (size_t)u * 256 + 4 * lane) = wi * nv + sd * kv; if (lane == 0) out[O_SM + u] = mt; }
            const float* Cs = args.in[I_SMC_] + (size_t)u * 65536; float* Co = out + O_SC + (size_t)u * 65536;
            float pc[32];
            const bf16_t* vrow = wsZ + (size_t)m * NZ + OFF_MV + h * 256 + 32 * wave;
#pragma unroll
            for (int r = 0; r < 32; ++r) {
                const int v = 32 * wave + r;
                const f32x4 c4 = __builtin_nontemporal_load((const f32x4*)(Cs + (size_t)v * 256 + 4 * lane));
                const float vv = bf2f(vrow[r]);
                pc[r] = (c4[0] * qv[0] + c4[1] * qv[1]) + (c4[2] * qv[2] + c4[3] * qv[3]);
                __builtin_nontemporal_store(wi * c4 + (sd * vv) * kv, (f32x4*)(Co + (size_t)v * 256 + 4 * lane));
            }
            reduce32(pc, lane);
            float hsq = 0.f;
            { const float vv = bf2f(vrow[lane >> 1]); const float hval = (wi * pc[0] + s * vv) / dn;
              if ((lane & 1) == 0) { hv[32 * wave + (lane >> 1)] = hval; hsq = hval * hval; } }
            hsq = wave_sum(hsq);
            if (lane == 0) red[wave] = hsq;
            __syncthreads();
            if (tid < 256) {
                float tot = 0.f;
#pragma unroll
                for (int w = 0; w < 8; ++w) tot += red[w];
                const float rstd = rsqrtf(tot * (1.f / 256.f) + EPS);
                const float og = bf2f(wsZ[(size_t)m * NZ + OFF_MO + h * 256 + tid]);
                wsY[(size_t)m * D + 1024 + h * 256 + tid] = (bf16_t)f2bf(hv[tid] * rstd * args.in[I_GML][tid] * sigmoidf_(og));
            }
        }
        }
        __syncthreads();
    }
    SEAM(5);

    REP(6) if (IN(6)) { PH_IDS
        for (int u = bid; u < 256; u += G) {
            const int bh = u >> 4, c = u & 15, b = bh >> 2, h = bh & 3, m0 = b * TT + c * 128;
            LAS float* ev = misc; LAS float* bb = misc + 128; LAS float* pmx = misc + 256; LAS float* nin = misc + 384;
            LAS unsigned char* Vl = lds;
            __syncthreads();
            if (tid < 128) { ev[tid] = wsGATES[(size_t)(m0 + tid) * 8 + h] + args.in[I_BI][h]; bb[tid] = logsigmoid_(wsGATES[(size_t)(m0 + tid) * 8 + 4 + h] + args.in[I_BF][h]); }
            if (tid >= 256) nin[tid - 256] = wsNIN[(size_t)u * 256 + tid - 256];
            __syncthreads();
            if (wave == 0) {
                const float x0 = bb[2 * lane], x1 = bb[2 * lane + 1], loc = x0 + x1; float inc = loc;
#pragma unroll
                for (int o = 1; o < 64; o <<= 1) { const float t = __shfl_up(inc, o); if (lane >= o) inc += t; }
                const float b0 = inc - x1, b1 = inc, e0 = ev[2 * lane] - b0, e1 = ev[2 * lane + 1] - b1;
                float im = fmaxf(e0, e1);
#pragma unroll
                for (int o = 1; o < 64; o <<= 1) { const float t = __shfl_up(im, o); if (lane >= o) im = fmaxf(im, t); }
                float ex = __shfl_up(im, 1); if (lane == 0) ex = -INFINITY;
                bb[2 * lane] = b0; bb[2 * lane + 1] = b1; ev[2 * lane] = e0; ev[2 * lane + 1] = e1;
                pmx[2 * lane] = fmaxf(ex, e0); pmx[2 * lane + 1] = im;
            }
            for (int idx = tid; idx < 128 * 32; idx += 512) { const int s = idx >> 5, ch = idx & 31;
                *(LAS u32x4*)(Vl + s * 528 + ch * 16) = *(const u32x4*)(wsZ + (size_t)(m0 + s) * NZ + OFF_MV + h * 256 + ch * 8); }
            __syncthreads();
            const float mc = wsMINB[u];
            const int fr = lane & 15, g4 = lane >> 4, q = fr >> 2, p = fr & 3, t = 16 * wave + fr;
            const bf16_t* qp = wsQm + (size_t)(m0 + t) * 1024 + h * 256 + 8 * g4;
            f32x4 sacc[8];
#pragma unroll
            for (int st = 0; st < 8; ++st) sacc[st] = (f32x4){0.f, 0.f, 0.f, 0.f};
#pragma unroll 2
            for (int ks = 0; ks < 8; ++ks) {
                const bf16x8 qf = ld8(qp + 32 * ks);
                const bf16_t* kp = wsKm + (size_t)(m0 + fr) * 1024 + h * 256 + 32 * ks + 8 * g4;
#pragma unroll
                for (int st = 0; st < 8; ++st) if (st <= wave) { const bf16x8 xk = ld8(kp + (size_t)(16 * st) * 1024); sacc[st] = MFMA16(xk, qf, sacc[st]); }
            }
            const float Mt = fmaxf(mc, pmx[t]);
            float rs = 0.f;
#pragma unroll
            for (int st = 0; st < 8; ++st) { const f32x4 e4 = *(const LAS f32x4*)(ev + 16 * st + 4 * g4);
#pragma unroll
                for (int r = 0; r < 4; ++r) { const int s = 16 * st + 4 * g4 + r; const float pv = (s <= t) ? sacc[st][r] * __expf(e4[r] - Mt) : 0.f; sacc[st][r] = pv; rs += pv; } }
            float nq = 0.f;
            f32x4 oacc[16];
#pragma unroll
            for (int vt = 0; vt < 16; ++vt) oacc[vt] = (f32x4){0.f, 0.f, 0.f, 0.f};
            const bf16_t* cin = wsCIN + (size_t)u * 65536 + (size_t)fr * 256 + 8 * g4;
#pragma unroll 2
            for (int ks = 0; ks < 8; ++ks) {
                const bf16x8 qf = ld8(qp + 32 * ks);
                const f32x4 n0 = *(const LAS f32x4*)(nin + 32 * ks + 8 * g4), n1 = *(const LAS f32x4*)(nin + 32 * ks + 8 * g4 + 4);
                nq += (bf2f((unsigned short)qf[0]) * n0[0] + bf2f((unsigned short)qf[1]) * n0[1]) + (bf2f((unsigned short)qf[2]) * n0[2] + bf2f((unsigned short)qf[3]) * n0[3])
                    + (bf2f((unsigned short)qf[4]) * n1[0] + bf2f((unsigned short)qf[5]) * n1[1]) + (bf2f((unsigned short)qf[6]) * n1[2] + bf2f((unsigned short)qf[7]) * n1[3]);
#pragma unroll
                for (int vt = 0; vt < 16; ++vt) { const bf16x8 xc = ld8(cin + (size_t)(16 * vt) * 256 + 32 * ks); oacc[vt] = MFMA16(xc, qf, oacc[vt]); }
            }
            rs += __shfl_xor(rs, 16); rs += __shfl_xor(rs, 32); nq += __shfl_xor(nq, 16); nq += __shfl_xor(nq, 32);
            const float wi = __expf(mc - Mt), den = wi * nq + rs, dn = fmaxf(fabsf(den), __expf(-(bb[t] + Mt)));
#pragma unroll
            for (int vt = 0; vt < 16; ++vt) oacc[vt] = oacc[vt] * wi;
#pragma unroll
            for (int pb = 0; pb < 4; ++pb) if (2 * pb <= wave) {
                u32x4 pw; pw.x = pk2(sacc[2 * pb][0], sacc[2 * pb][1]); pw.y = pk2(sacc[2 * pb][2], sacc[2 * pb][3]); pw.z = pk2(sacc[2 * pb + 1][0], sacc[2 * pb + 1][1]); pw.w = pk2(sacc[2 * pb + 1][2], sacc[2 * pb + 1][3]);
                const bf16x8 yp = __builtin_bit_cast(bf16x8, pw);
                const int rb = (32 * pb + 4 * g4 + q) * 528 + 8 * p;
#pragma unroll
                for (int vt = 0; vt < 16; ++vt) { const bf16x8 xv = cat8(tr_read(Vl + rb + 32 * vt), tr_read(Vl + rb + 16 * 528 + 32 * vt)); oacc[vt] = MFMA16(xv, yp, oacc[vt]); }
            }
            const float inv = 1.f / dn; float ss = 0.f;
#pragma unroll
            for (int vt = 0; vt < 16; ++vt) { oacc[vt] = oacc[vt] * inv; ss += (oacc[vt][0] * oacc[vt][0] + oacc[vt][1] * oacc[vt][1]) + (oacc[vt][2] * oacc[vt][2] + oacc[vt][3] * oacc[vt][3]); }
            ss += __shfl_xor(ss, 16); ss += __shfl_xor(ss, 32);
            const float rstd = rsqrtf(ss * (1.f / 256.f) + EPS);
#pragma unroll
            for (int vt = 0; vt < 16; ++vt) {
                const int v0 = 16 * vt + 4 * g4; const f32x4 gg = *(const f32x4*)(args.in[I_GML] + v0);
                const u32x2 ow = *(const u32x2*)(wsZ + (size_t)(m0 + t) * NZ + OFF_MO + h * 256 + v0);
                const float o0 = oacc[vt][0] * rstd * gg[0] * sigmoidf_(bflo(ow.x)), o1 = oacc[vt][1] * rstd * gg[1] * sigmoidf_(bfhi(ow.x));
                const float o2 = oacc[vt][2] * rstd * gg[2] * sigmoidf_(bflo(ow.y)), o3 = oacc[vt][3] * rstd * gg[3] * sigmoidf_(bfhi(ow.y));
                u32x2 w; w.x = pk2(o0, o1); w.y = pk2(o2, o3); *(u32x2*)(wsY + (size_t)(m0 + t) * D + 1024 + h * 256 + v0) = w;
            }
        }
        __syncthreads();
    }
    SEAM(6);

    REP(7) if (IN(7)) { PH_IDS
        { const pg8::Gemm g = pg8::mk_gemm(wsY, wsWoutT, D * 2, D * 2, D, 0); pg8::StaticOrder S; S.init(32, 8, G, bid);
          EpiResNorm<float> E{args.in[I_XP], wsX1, wsXN, args.in[I_GX], wsSS}; pg8::gemm_phase<EpiResNorm<float>, true, true>(lds, g, S, E, wave); }
        skinny_gemm(wsY + (size_t)MP * D, D, wsWoutT, D, D, D, 1, 0, 64, MP, FResNorm<float>{args.in[I_XS], MP, wsX1, wsXN, args.in[I_GX], wsSS}, 0, wave, (LAS float*)lds);
        if (bid >= 64) { convert_matrix(args.in[I_WCQ], D, D, D, wsWcqT, D, (LAS float*)(lds + wave * 16384), (bid - 64) * 8 + wave, (G - 64) * 8, lane);
                         convert_matrix(args.in[I_WCO], D, D, D, wsWcoT, D, (LAS float*)(lds + wave * 16384), (bid - 64) * 8 + wave, (G - 64) * 8, lane); }
    }
    SEAM(7);

    REP(9) if (IN(9)) { PH_IDS
        const float qs = 0.04419417382415922f;
        { const pg8::Gemm g = pg8::mk_gemm(wsXN, wsWcqT, D * 2, D * 2, D, 0); pg8::StaticOrder S; S.init(32, 8, G, bid);
          pg8::EpiF8<FStoreBf16> E{{wsQC, D, qs, 0, wsSS}}; pg8::gemm_phase<pg8::EpiF8<FStoreBf16>, true, true>(lds, g, S, E, wave); }
        skinny_gemm(wsXN + (size_t)MP * D, D, wsWcqT, D, D, D, 1, 0, 64, MP, FStoreBf16{wsQC, D, qs, 0, wsSS}, 0, wave, (LAS float*)lds);
        if (bid >= 64) convert_matrix(args.in[I_WUP], DFF, D, DFF, wsWupT, D, (LAS float*)(lds + wave * 16384), (bid - 64) * 8 + wave, (G - 64) * 8, lane);
    }
    SEAM(9);

    REP(10) if (IN(10)) { PH_IDS
        { pg8::Gemm g{(const char*)wsQC, (const char*)wsMK, D * 2, D * 2, 512, (size_t)256 * D * 2, 0, 1024, 1024, (size_t)256 * D * 2, 0x7fffffff, 0x7fffffff, 0, 0}; pg8::StaticOrder S; S.init(32, 4, G, bid);
          EpiSoftmax E{wsPB, misc}; pg8::gemm_phase<EpiSoftmax, true, true>(lds, g, S, E, wave); }
        { pg8::Gemm g{(const char*)wsWcoT, (const char*)wsMVt, D * 2, D * 2, 512, (size_t)256 * D * 2, 0, 1024, 1024, 0, 3, 3, 2, (size_t)256 * D * 2}; pg8::StaticOrder S; S.init(8, 16, G, bid - 128);
          pg8::EpiF8<FVw> E{{wsVW}}; pg8::gemm_phase<pg8::EpiF8<FVw>, true, true>(lds, g, S, E, wave); }
        for (int u = bid; u < 512; u += G) {
            const int sb = u >> 2, h = u & 3, m = MP + sb;
            LAS float* scr = misc;
            LAS float* part = (LAS float*)lds;
            __syncthreads();
            const u32x2 qa = *(const u32x2*)(wsQC + (size_t)m * D + h * 512 + 4 * lane), qb = *(const u32x2*)(wsQC + (size_t)m * D + h * 512 + 256 + 4 * lane);
            const f32x4 q0 = (f32x4){bflo(qa.x), bfhi(qa.x), bflo(qa.y), bfhi(qa.y)}, q1 = (f32x4){bflo(qb.x), bfhi(qb.x), bflo(qb.y), bfhi(qb.y)};
            const float* kb = args.in[I_CK] + ((size_t)sb * 256 * 4 + h) * 512 + 4 * lane + (size_t)(32 * wave) * 2048;
            const float* vb = args.in[I_CV] + ((size_t)sb * 256 * 4 + h) * 512 + 4 * lane + (size_t)(32 * wave) * 2048;
            float pa[32];
#pragma unroll
            for (int i = 0; i < 32; ++i) { const f32x4 a = __builtin_nontemporal_load((const f32x4*)(kb + (size_t)i * 2048)), c4 = __builtin_nontemporal_load((const f32x4*)(kb + (size_t)i * 2048 + 256));
                pa[i] = ((a[0] * q0[0] + a[1] * q0[1]) + (a[2] * q0[2] + a[3] * q0[3])) + ((c4[0] * q1[0] + c4[1] * q1[1]) + (c4[2] * q1[2] + c4[3] * q1[3])); }
            reduce32(pa, lane);
            if ((lane & 1) == 0) scr[32 * wave + (lane >> 1)] = pa[0];
            __syncthreads();
            const f32x4 s4 = *(const LAS f32x4*)(scr + 4 * lane);
            const float mx = wave_max(fmaxf(fmaxf(s4[0], s4[1]), fmaxf(s4[2], s4[3])));
            const float sm = wave_sum((__expf(s4[0] - mx) + __expf(s4[1] - mx)) + (__expf(s4[2] - mx) + __expf(s4[3] - mx)));
            const float inv = 1.f / sm;
            f32x4 o0 = (f32x4){0.f, 0.f, 0.f, 0.f}, o1 = (f32x4){0.f, 0.f, 0.f, 0.f};
#pragma unroll 16
            for (int i = 0; i < 32; ++i) { const float pr = __expf(scr[32 * wave + i] - mx) * inv;
                const f32x4 a = __builtin_nontemporal_load((const f32x4*)(vb + (size_t)i * 2048)), c4 = __builtin_nontemporal_load((const f32x4*)(vb + (size_t)i * 2048 + 256));
                o0 = o0 + pr * a; o1 = o1 + pr * c4; }
            *(LAS f32x4*)(part + wave * 512 + 4 * lane) = o0; *(LAS f32x4*)(part + wave * 512 + 256 + 4 * lane) = o1;
            __syncthreads();
            float tot = 0.f;
#pragma unroll
            for (int w = 0; w < 8; ++w) tot += part[w * 512 + tid];
            wsOC[(size_t)m * D + h * 512 + tid] = (bf16_t)f2bf(tot);
        }
        __syncthreads();
    }
    SEAM(10);

    REP(11) if (IN(11)) { PH_IDS
        { pg8::Gemm g{(const char*)wsPB, (const char*)wsVW, 2048, 2048, 1024, (size_t)256 * 2048, 0, 0, (size_t)256 * 2048, (size_t)D * 2048, 0x7fffffff, 0x7fffffff, 0, 0}; pg8::StaticOrder S; S.init(32, 8, G, bid);
          EpiResNorm<bf16_t> E{wsX1, wsX2, wsXN, args.in[I_GFFN], wsSS + MT}; pg8::gemm_phase<EpiResNorm<bf16_t>, true, true>(lds, g, S, E, wave); }
        skinny_gemm(wsOC + (size_t)MP * D, D, wsWcoT, D, D, D, 1, 0, 64, MP, FResNorm<bf16_t>{wsX1, 0, wsX2, wsXN, args.in[I_GFFN], wsSS + MT}, 0, wave, (LAS float*)lds);
        if (bid >= 64) convert_matrix(args.in[I_WDN], D, DFF, D, wsWdnT, DFF, (LAS float*)(lds + wave * 16384), (bid - 64) * 8 + wave, (G - 64) * 8, lane);
    }
    SEAM(11);

    REP(13) if (IN(13)) { PH_IDS
        { const pg8::Gemm g = pg8::mk_gemm(wsXN, wsWupT, D * 2, D * 2, D, 0); pg8::StaticOrder S; S.init(32, 32, G, bid);
          pg8::EpiF8<FStoreBf16> E{{wsU, DFF, 1.f, 1, wsSS + MT}}; pg8::gemm_phase<pg8::EpiF8<FStoreBf16>, true, true>(lds, g, S, E, wave); }
        skinny_gemm(wsXN + (size_t)MP * D, D, wsWupT, D, D, DFF, 1, 0, 256, MP, FStoreBf16{wsU, DFF, 1.f, 1, wsSS + MT}, 0, wave, (LAS float*)lds);
    }
    SEAM(13);

    REP(14) if (IN(14)) { PH_IDS
        { const pg8::Gemm g = pg8::mk_gemm(wsU, wsWdnT, DFF * 2, DFF * 2, DFF, 0); pg8::StaticOrder S; S.init(32, 8, G, bid);
          pg8::EpiF8<FResB> E{{wsX2, wsX1}}; pg8::gemm_phase<pg8::EpiF8<FResB>, true, false>(lds, g, S, E, wave); }
        skinny_gemm(wsU + (size_t)MP * DFF, DFF, wsWdnT, DFF, DFF, D, 4, 0, 256, 0, FPart{wsPART, D}, 128, wave, (LAS float*)lds);
    }
    SEAM(14);

    REP(15) if (IN(15)) { PH_IDS
        f32x4 gfin[8]; load_gain(args.in[I_GFIN], lane, gfin);
        for (int m = gw; m < MT; m += NGW) {
            f32x4 v[8]; float ss = 0.f;
#pragma unroll
            for (int j = 0; j < 8; ++j) {
                if (m < MP) v[j] = ld4_res(wsX1 + (size_t)m * D + 256 * j + 4 * lane);
                else { const size_t o = (size_t)(m - MP) * D + 256 * j + 4 * lane; v[j] = ld4_res(wsX2 + (size_t)m * D + 256 * j + 4 * lane);
#pragma unroll
                    for (int s = 0; s < 4; ++s) v[j] = v[j] + *(const f32x4*)(wsPART + (size_t)s * 128 * D + o); }
                ss += (v[j][0] * v[j][0] + v[j][1] * v[j][1]) + (v[j][2] * v[j][2] + v[j][3] * v[j][3]);
            }
            const float rstd = rsqrtf(wave_sum(ss) * (1.f / D) + EPS);
            float* o = (m < MP) ? out + O_YP + (size_t)m * D : out + O_YS + (size_t)(m - MP) * D;
#pragma unroll
            for (int j = 0; j < 8; ++j) __builtin_nontemporal_store(v[j] * rstd * gfin[j], (f32x4*)(o + 256 * j + 4 * lane));
        }
    }
#undef IN
#undef SEAM
}

extern "C" void kernel_launch(void* const* d_in, const int* in_sizes, int n_in, void* d_out, int out_size, void* d_ws, size_t ws_size, hipStream_t stream) {
    static int grid = 0;
    if (grid == 0) {
        int dev = 0, cus = 0, per_cu = 0;
        if (n_in != 39 || ws_size < WS_END) { fprintf(stderr, "kernel_launch: unexpected n_in %d / ws %zu\n", n_in, ws_size); grid = -1; return; }
        hipGetDevice(&dev);
        hipDeviceGetAttribute(&cus, hipDeviceAttributeMultiprocessorCount, dev);
        if (hipFuncSetAttribute((const void*)mega_fwd, hipFuncAttributeMaxDynamicSharedMemorySize, LDS_BYTES) != hipSuccess) { fprintf(stderr, "kernel_launch: hipFuncSetAttribute failed\n"); grid = -1; return; }
        if (hipOccupancyMaxActiveBlocksPerMultiprocessor(&per_cu, (const void*)mega_fwd, 512, LDS_BYTES) != hipSuccess || per_cu < 1) { fprintf(stderr, "kernel_launch: occupancy query says %d\n", per_cu); per_cu = 1; }
        (void)hipGetLastError();
        grid = cus;
    }
    if (grid < 0) return;
    Args a{};
    for (int i = 0; i < 39; ++i) a.in[i] = (const float*)d_in[i];
    a.out = (float*)d_out; a.ws = (unsigned char*)d_ws; a.ph_lo = 0; a.ph_hi = NPH;
    if (hipMemsetAsync((char*)d_ws + WS_CTL, 0, 65536, stream) != hipSuccess) { fprintf(stderr, "kernel_launch: memset failed\n"); return; }
    hipLaunchKernelGGL(mega_fwd, dim3(grid), dim3(512), LDS_BYTES, stream, a);
    hipError_t e = hipPeekAtLastError();
    if (e != hipSuccess) fprintf(stderr, "kernel_launch: launch failed: %s (grid %d)\n", hipGetErrorString(e), grid);
}
```
